# Optimizing an MI355X kernel written in HIP

```python
import math
import jax, jax.numpy as jnp
from jax import lax
import numpy as np

D_MODEL = 1024
BATCH = 8
SEQ = 2048
DEPTH = 2

A_HEADS = 4
A_DH = 64
A_DV = 2 * A_DH
B_HEADS = 8
B_DQLAT = 128
B_DLAT = 128
B_DV = 64
IDX_HEADS = 8
IDX_DH = 32
TOPK_MAX = 256
AB_WIDTH = A_HEADS * A_DV + B_HEADS * B_DV
AB_SPLITS = (A_HEADS * 2 * A_DH, A_HEADS * 2 * A_DH, A_HEADS * A_DV,
             B_DQLAT, B_DLAT, IDX_DH, IDX_HEADS, AB_WIDTH)
C_HEADS = 8
C_KV_HEADS = 2
C_DH = 64
WINDOW = 128
D_CH = 512
CONV_W = 31
CD_WIDTH = C_HEADS * C_DH + D_CH
CD_SPLITS = (C_HEADS * C_DH, C_KV_HEADS * C_DH, C_KV_HEADS * C_DH, D_CH, D_CH, CD_WIDTH)

Q_BLOCK = 128
EPS = 1e-6
N_AB = (DEPTH + 1) // 2
N_CD = DEPTH // 2

kernel_name = "hybrid_diffattn_dsa_swa_conformer_adaln"


def rmsnorm(x, g):
    xf = x.astype(jnp.float32)
    y = xf * lax.rsqrt(jnp.mean(xf * xf, axis=-1, keepdims=True) + EPS)
    return (y * g.astype(jnp.float32)).astype(x.dtype)


def layernorm(x, g, b):
    xf = x.astype(jnp.float32)
    mu = jnp.mean(xf, axis=-1, keepdims=True)
    var = jnp.mean(jnp.square(xf - mu), axis=-1, keepdims=True)
    y = (xf - mu) * lax.rsqrt(var + EPS)
    return (y * g.astype(jnp.float32) + b.astype(jnp.float32)).astype(x.dtype)


def alibi_slopes(n):
    return jnp.asarray(np.power(2.0, -8.0 * np.arange(1, n + 1) / n).astype(np.float32))


def _split(t, sizes):
    offs, acc = [], 0
    for s_ in sizes[:-1]:
        acc += s_
        offs.append(acc)
    return jnp.split(t, offs, axis=-1)


def _to_blocks(t, nb):
    return t.reshape(t.shape[0], nb, Q_BLOCK, *t.shape[2:]).swapaxes(0, 1)


def _from_blocks(t):
    t = t.swapaxes(0, 1)
    return t.reshape(t.shape[0], t.shape[1] * t.shape[2], *t.shape[3:])


def diff_attention(q, k, v, lam, slopes):
    S = q.shape[1]
    nb = S // Q_BLOCK
    kpos = jnp.arange(S)
    scale = A_DH ** -0.5

    def one_block(args):
        qblk, i = args
        qpos = i * Q_BLOCK + jnp.arange(Q_BLOCK)
        s = jnp.einsum('bqhcd,bkhcd->bhcqk', qblk, k).astype(jnp.float32) * scale
        dist = (qpos[:, None] - kpos[None, :]).astype(jnp.float32)
        s = jnp.where(dist >= 0, s - slopes[:, None, None, None] * dist, -jnp.inf)
        p = jax.nn.softmax(s, axis=-1)
        w = p[:, :, 0] - lam * p[:, :, 1]
        return jnp.einsum('bhqk,bkhd->bqhd', w.astype(v.dtype), v)

    out = lax.map(one_block, (_to_blocks(q, nb), jnp.arange(nb)))
    return _from_blocks(out)


def dsa_attention(q_lat, kv_lat, q_idx, k_idx, w_idx, slopes):
    S = kv_lat.shape[1]
    topk = min(TOPK_MAX, S // 4)
    nb = S // Q_BLOCK
    kpos = jnp.arange(S)
    scale = B_DLAT ** -0.5

    def one_block(args):
        ql, qi, wi, i = args
        qpos = i * Q_BLOCK + jnp.arange(Q_BLOCK)
        causal = kpos[None, :] <= qpos[:, None]
        rel = jax.nn.relu(jnp.einsum('bqhd,bkd->bqhk', qi, k_idx))
        iscore = jnp.einsum('bqh,bqhk->bqk', wi, rel).astype(jnp.float32)
        iscore = jnp.where(causal[None], iscore, -jnp.inf)
        _, sel = lax.top_k(iscore, topk)
        kv_sel = jax.vmap(lambda lat, ix: lat[ix])(kv_lat, sel)
        s = jnp.einsum('bqhd,bqkd->bhqk', ql, kv_sel).astype(jnp.float32) * scale
        dist = (qpos[None, :, None] - sel).astype(jnp.float32)
        s = jnp.where((dist >= 0)[:, None], s - slopes[None, :, None, None] * dist[:, None], -jnp.inf)
        p = jax.nn.softmax(s, axis=-1)
        return jnp.einsum('bhqk,bqkd->bqhd', p.astype(kv_sel.dtype), kv_sel)

    out = lax.map(one_block, (_to_blocks(q_lat, nb), _to_blocks(q_idx, nb),
                              _to_blocks(w_idx, nb), jnp.arange(nb)))
    return _from_blocks(out)


def sliding_window_gqa(q, k, v, sinks, slopes):
    Bsz, S, H, dh = q.shape
    G = k.shape[2]
    R = H // G
    nb = S // WINDOW
    qb = q.reshape(Bsz, nb, WINDOW, G, R, dh)

    def band(t):
        tb = t.reshape(Bsz, nb, WINDOW, G, dh)
        prev = jnp.concatenate([jnp.zeros_like(tb[:, :1]), tb[:, :-1]], axis=1)
        return jnp.concatenate([prev, tb], axis=2)

    kb, vb = band(k), band(v)
    qpos = jnp.arange(WINDOW) + WINDOW
    kpos = jnp.arange(2 * WINDOW)
    dist = qpos[:, None] - kpos[None, :]
    valid = (dist >= 0) & (dist < WINDOW)
    valid = valid[None] & ((jnp.arange(nb)[:, None, None] > 0) | (kpos >= WINDOW)[None, None, :])
    s = jnp.einsum('bnqgrd,bnkgd->bngrqk', qb, kb).astype(jnp.float32) * (dh ** -0.5)
    s = s - slopes.reshape(G, R)[:, :, None, None] * dist.astype(jnp.float32)
    s = jnp.where(valid[None, :, None, None], s, -jnp.inf)
    sink = jnp.broadcast_to(sinks.astype(jnp.float32).reshape(G, R)[:, :, None, None], s.shape[:-1] + (1,))
    p = jax.nn.softmax(jnp.concatenate([s, sink], axis=-1), axis=-1)[..., :-1]
    o = jnp.einsum('bngrqk,bnkgd->bnqgrd', p.astype(v.dtype), vb)
    return o.reshape(Bsz, S, H, dh)


def conformer_conv(val, gate, dw_w, dw_b, ln_g, ln_b):
    h = val * jax.nn.sigmoid(gate)
    hp = jnp.pad(h, ((0, 0), (CONV_W - 1, 0), (0, 0)))
    h = lax.conv_general_dilated(hp, dw_w[:, None, :], window_strides=(1,), padding='VALID',
                                 dimension_numbers=('NWC', 'WIO', 'NWC'),
                                 feature_group_count=D_CH) + dw_b
    return jax.nn.silu(layernorm(h, ln_g, ln_b))


def mixer_ab(h, layer_idx, w_in, q_norm_g, kv_norm_g, w_uq, w_qidx, w_uv,
             lam_q1, lam_k1, lam_q2, lam_k2, subln_g, w_out):
    Bsz, S, _ = h.shape
    qa, ka, va, cq, ckv, kidx, widx, gate = _split(h @ w_in, AB_SPLITS)
    lam_init = 0.8 - 0.6 * math.exp(-0.3 * layer_idx)
    lam = (jnp.exp(jnp.sum(lam_q1.astype(jnp.float32) * lam_k1.astype(jnp.float32)))
           - jnp.exp(jnp.sum(lam_q2.astype(jnp.float32) * lam_k2.astype(jnp.float32))) + lam_init)
    oa = diff_attention(qa.reshape(Bsz, S, A_HEADS, 2, A_DH), ka.reshape(Bsz, S, A_HEADS, 2, A_DH),
                        va.reshape(Bsz, S, A_HEADS, A_DV), lam, alibi_slopes(A_HEADS))
    oa = rmsnorm(oa, subln_g) * (1.0 - lam_init)
    cq = rmsnorm(cq, q_norm_g)
    ckv = rmsnorm(ckv, kv_norm_g)
    q_lat = jnp.einsum('bsc,chd->bshd', cq, w_uq)
    q_idx = jnp.einsum('bsc,chd->bshd', cq, w_qidx)
    ob = dsa_attention(q_lat, ckv, q_idx, kidx, widx, alibi_slopes(B_HEADS))
    ob = jnp.einsum('bshd,hde->bshe', ob, w_uv)
    y = jnp.concatenate([oa.reshape(Bsz, S, -1), ob.reshape(Bsz, S, -1)], axis=-1) * jax.nn.silu(gate)
    return y @ w_out


def mixer_cd(h, w_in, sinks, dw_w, dw_b, ln_g, ln_b, w_out):
    Bsz, S, _ = h.shape
    qc, kc, vc, dval, dgate, gate = _split(h @ w_in, CD_SPLITS)
    oc = sliding_window_gqa(qc.reshape(Bsz, S, C_HEADS, C_DH), kc.reshape(Bsz, S, C_KV_HEADS, C_DH),
                            vc.reshape(Bsz, S, C_KV_HEADS, C_DH), sinks, alibi_slopes(C_HEADS))
    od = conformer_conv(dval, dgate, dw_w, dw_b, ln_g, ln_b)
    y = jnp.concatenate([oc.reshape(Bsz, S, -1), od], axis=-1) * jax.nn.silu(gate)
    return y @ w_out


def setup_inputs(seed: int = 0) -> dict:
    key = jax.random.key(seed)
    ks = jax.random.split(key, 32)
    f32 = jnp.float32
    nrm = lambda k, shape, s: jax.random.normal(k, shape, f32) * s
    ab_cols = sum(AB_SPLITS)
    cd_cols = sum(CD_SPLITS)
    return {
        'x': nrm(ks[0], (BATCH, SEQ, D_MODEL), 1.0),
        'c': nrm(ks[1], (BATCH, D_MODEL), 1.0),
        'ada_w': nrm(ks[2], (DEPTH, D_MODEL, 3 * D_MODEL), D_MODEL ** -0.5),
        'ada_b': nrm(ks[3], (DEPTH, 3 * D_MODEL), 0.02),
        'norm_g': 1.0 + nrm(ks[4], (DEPTH, D_MODEL), 0.02),
        'ab_w_in': nrm(ks[5], (N_AB, D_MODEL, ab_cols), D_MODEL ** -0.5),
        'ab_q_norm_g': 1.0 + nrm(ks[6], (N_AB, B_DQLAT), 0.02),
        'ab_kv_norm_g': 1.0 + nrm(ks[7], (N_AB, B_DLAT), 0.02),
        'ab_w_uq': nrm(ks[8], (N_AB, B_DQLAT, B_HEADS, B_DLAT), B_DQLAT ** -0.5),
        'ab_w_qidx': nrm(ks[9], (N_AB, B_DQLAT, IDX_HEADS, IDX_DH), B_DQLAT ** -0.5),
        'ab_w_uv': nrm(ks[10], (N_AB, B_HEADS, B_DLAT, B_DV), B_DLAT ** -0.5),
        'ab_lam_q1': nrm(ks[11], (N_AB, A_DH), 0.1),
        'ab_lam_k1': nrm(ks[12], (N_AB, A_DH), 0.1),
        'ab_lam_q2': nrm(ks[13], (N_AB, A_DH), 0.1),
        'ab_lam_k2': nrm(ks[14], (N_AB, A_DH), 0.1),
        'ab_subln_g': 1.0 + nrm(ks[15], (N_AB, A_DV), 0.02),
        'ab_w_out': nrm(ks[16], (N_AB, AB_WIDTH, D_MODEL), AB_WIDTH ** -0.5),
        'cd_w_in': nrm(ks[17], (N_CD, D_MODEL, cd_cols), D_MODEL ** -0.5),
        'cd_sinks': nrm(ks[18], (N_CD, C_HEADS), 0.5),
        'cd_dw_w': nrm(ks[19], (N_CD, CONV_W, D_CH), CONV_W ** -0.5),
        'cd_dw_b': nrm(ks[20], (N_CD, D_CH), 0.02),
        'cd_ln_g': 1.0 + nrm(ks[21], (N_CD, D_CH), 0.02),
        'cd_ln_b': nrm(ks[22], (N_CD, D_CH), 0.02),
        'cd_w_out': nrm(ks[23], (N_CD, CD_WIDTH, D_MODEL), CD_WIDTH ** -0.5),
        'final_g': 1.0 + nrm(ks[24], (D_MODEL,), 0.02),
    }


def reference(x, c, ada_w, ada_b, norm_g, ab_w_in, ab_q_norm_g, ab_kv_norm_g, ab_w_uq, ab_w_qidx,
              ab_w_uv, ab_lam_q1, ab_lam_k1, ab_lam_q2, ab_lam_k2, ab_subln_g, ab_w_out,
              cd_w_in, cd_sinks, cd_dw_w, cd_dw_b, cd_ln_g, cd_ln_b, cd_w_out, final_g):
    mods = jnp.einsum('bd,ldm->lbm', jax.nn.silu(c), ada_w) + ada_b[:, None]
    for l in range(DEPTH):
        shift, scale, gate = jnp.split(mods[l], 3, axis=-1)
        h = rmsnorm(x, norm_g[l]) * (1.0 + scale[:, None]) + shift[:, None]
        j = l // 2
        if l % 2 == 0:
            y = mixer_ab(h, l, ab_w_in[j], ab_q_norm_g[j], ab_kv_norm_g[j], ab_w_uq[j], ab_w_qidx[j],
                         ab_w_uv[j], ab_lam_q1[j], ab_lam_k1[j], ab_lam_q2[j], ab_lam_k2[j],
                         ab_subln_g[j], ab_w_out[j])
        else:
            y = mixer_cd(h, cd_w_in[j], cd_sinks[j], cd_dw_w[j], cd_dw_b[j], cd_ln_g[j], cd_ln_b[j],
                         cd_w_out[j])
        x = x + gate[:, None] * y
    return rmsnorm(x, final_g)
```

```cpp
#include <hip/hip_runtime.h>
#include <cstdio>
#include <cstdint>
namespace pg8 {
#define PG8_LAS __attribute__((address_space(3)))
typedef unsigned short bf16_t;
typedef short bf16x8 __attribute__((ext_vector_type(8)));
typedef float f32x4 __attribute__((ext_vector_type(4)));
typedef unsigned u32x4 __attribute__((ext_vector_type(4)));
constexpr int BM = 256, BK = 64, HALF = 128, HTB = HALF * BK * 2  , STAGE_BYTES = 8 * HTB, NXCD = 8, WGM = 8;

__host__ __device__ __forceinline__ int lds_byte(int r, int c) { const int st = (r >> 4) * 2 + (c >> 5), rr = r & 15, cc = c & 31, ob = rr * 64 + cc * 2; return st * 1024 + (ob ^ (((ob >> 9) & 1) << 5)); }
__host__ __device__ __forceinline__ void stage_rc(int b, int& R, int& C) { const int st = b / 1024, sb = b % 1024, swz = sb ^ (((sb >> 9) & 1) << 5); R = (st >> 1) * 16 + swz / 64; C = (st & 1) * 32 + (swz % 64) / 2; }
__host__ __device__ __forceinline__ int perm32(int rho) { const int n = rho >> 4, i = rho & 15; return 8 * (i >> 2) + 4 * n + (i & 3); }

struct Unit { int pm, pn; };
struct Gemm { const bf16_t* A; const bf16_t* Bt; int M, N, K, lda, ldb; };

struct StaticOrder {
    int nM, nN, nwg, G, c;
    __host__ __device__ void init(int M, int N, int G_, int c_) { nM = M / BM; nN = N / BM; nwg = nM * nN; G = G_; c = c_; }
    __host__ __device__ bool next(int i, Unit& u) const {
        const long L = (long)i * G + c; if (L >= nwg) return false;
        int wgid = (int)L; { const int q = nwg / NXCD, r = nwg % NXCD, xcd = wgid % NXCD, off = wgid / NXCD; wgid = (xcd < r ? xcd * (q + 1) : r * (q + 1) + (xcd - r) * q) + off; }
        const int nig = WGM * nN, gid = wgid / nig, fm = gid * WGM, gsz = (nM - fm) < WGM ? (nM - fm) : WGM;
        u.pm = fm + ((wgid % nig) % gsz); u.pn = (wgid % nig) / gsz; return true;
    }
    __device__ __forceinline__ void a_ready(const Unit&) const {}
    __device__ __forceinline__ void done(const Unit&) const {}
};

__device__ __forceinline__ unsigned cvt_pk_bf16(float lo, float hi) { unsigned r; asm volatile("v_cvt_pk_bf16_f32 %0, %1, %2" : "=v"(r) : "v"(lo), "v"(hi)); return r; }

struct EpiStoreBf16 {
    static constexpr bool PERM = true, AFTER_DRAIN = false;
    bf16_t* O; int ldc; float* stats; int stat_pn;
    __device__ __forceinline__ void operator()(const f32x4 (&acc)[2][2][4][2], const Unit& u, int wr, int wc, int fr, int fq) const {
        const int row0 = u.pm * BM + wr * 64 + fr, col0 = u.pn * BM + wc * 32 + 8 * fq;
#pragma unroll
        for (int ai = 0; ai < 2; ++ai)
#pragma unroll
            for (int m = 0; m < 4; ++m) { bf16_t* rowp = O + (size_t)(row0 + ai * HALF + m * 16) * ldc + col0;
#pragma unroll
                for (int bj = 0; bj < 2; ++bj) { const f32x4 v0 = acc[ai][bj][m][0], v1 = acc[ai][bj][m][1];
                    u32x4 w; w.x = cvt_pk_bf16(v0[0], v0[1]); w.y = cvt_pk_bf16(v0[2], v0[3]); w.z = cvt_pk_bf16(v1[0], v1[1]); w.w = cvt_pk_bf16(v1[2], v1[3]);
                    *(u32x4*)(rowp + bj * HALF) = w; } }
        if (stats != nullptr && u.pn == stat_pn) {
#pragma unroll
            for (int ai = 0; ai < 2; ++ai)
#pragma unroll
                for (int m = 0; m < 4; ++m)
#pragma unroll
                    for (int bj = 0; bj < 2; ++bj) { const f32x4 v0 = acc[ai][bj][m][0], v1 = acc[ai][bj][m][1];
                        float s = (v0[0] * v0[0] + v0[1] * v0[1]) + (v0[2] * v0[2] + v0[3] * v0[3]) + (v1[0] * v1[0] + v1[1] * v1[1]) + (v1[2] * v1[2] + v1[3] * v1[3]);
                        s += __shfl_xor(s, 16); s += __shfl_xor(s, 32);
                        if (fq == 0) atomicAdd(stats + (size_t)(row0 + ai * HALF + m * 16) * 2 + bj, s); }
        }
    }
};
struct EpiScaleBf16 {
    static constexpr bool PERM = true, AFTER_DRAIN = false;
    bf16_t* O; int ldc; const float* stats; int pn_split; float eps;
    __device__ __forceinline__ void operator()(const f32x4 (&acc)[2][2][4][2], const Unit& u, int wr, int wc, int fr, int fq) const {
        const int row0 = u.pm * BM + wr * 64 + fr, col0 = u.pn * BM + wc * 32 + 8 * fq, si = (u.pn < pn_split) ? 0 : 1;
#pragma unroll
        for (int ai = 0; ai < 2; ++ai)
#pragma unroll
            for (int m = 0; m < 4; ++m) { const int row = row0 + ai * HALF + m * 16; bf16_t* rowp = O + (size_t)row * ldc + col0;
                const float rs = 1.0f / sqrtf(stats[(size_t)row * 2 + si] * (1.0f / 128.0f) + eps);
#pragma unroll
                for (int bj = 0; bj < 2; ++bj) { const f32x4 v0 = acc[ai][bj][m][0] * rs, v1 = acc[ai][bj][m][1] * rs;
                    u32x4 w; w.x = cvt_pk_bf16(v0[0], v0[1]); w.y = cvt_pk_bf16(v0[2], v0[3]); w.z = cvt_pk_bf16(v1[0], v1[1]); w.w = cvt_pk_bf16(v1[2], v1[3]);
                    *(u32x4*)(rowp + bj * HALF) = w; } }
    }
};
struct EpiResid {
    static constexpr bool PERM = false, AFTER_DRAIN = false;
    const float* resid; float* out; const float* gate; int gstride;
    __device__ __forceinline__ void operator()(const f32x4 (&acc)[2][2][4][2], const Unit& u, int wr, int wc, int fr, int fq) const {
        const int row0 = u.pm * BM + wr * 64 + fr, col0 = u.pn * BM + wc * 32 + 4 * fq;
        const float* gp = gate + (size_t)(u.pm >> 3) * gstride + col0;
        f32x4 gv[2][2];
#pragma unroll
        for (int bj = 0; bj < 2; ++bj)
#pragma unroll
            for (int n = 0; n < 2; ++n) gv[bj][n] = *(const f32x4*)(gp + bj * HALF + n * 16);
#pragma unroll
        for (int ai = 0; ai < 2; ++ai)
#pragma unroll
            for (int m = 0; m < 4; ++m) { const size_t off = (size_t)(row0 + ai * HALF + m * 16) * 1024 + col0;
#pragma unroll
                for (int bj = 0; bj < 2; ++bj)
#pragma unroll
                    for (int n = 0; n < 2; ++n) { const f32x4 r = *(const f32x4*)(resid + off + bj * HALF + n * 16); *(f32x4*)(out + off + bj * HALF + n * 16) = r + gv[bj][n] * acc[ai][bj][m][n]; }
                if (m & 1) asm volatile("" ::: "memory"); }
    }
};

template <class Epi, class Sched, bool ALIGN_EPI = false, bool SP2 = false>
__device__ __forceinline__ void gemm_phase(PG8_LAS unsigned char* lds, const Gemm g, const Sched& S, const Epi& E) {
    const int tid = threadIdx.x, wid = __builtin_amdgcn_readfirstlane(tid >> 6), lane = tid & 63, wr = wid >> 2, wc = wid & 3, fr = lane & 15, fq = lane >> 4;
    const int K = g.K, nt = K / BK;
    unsigned voffA[2], voffB[2];
#pragma unroll
    for (int i = 0; i < 2; ++i) { int R, C; stage_rc(tid * 16 + i * 8192, R, C); const int Rb = Epi::PERM ? ((R & ~31) + perm32(R & 31)) : R;
        voffA[i] = (unsigned)(R * g.lda + C) * 2u; voffB[i] = (unsigned)(Rb * g.ldb + C) * 2u; }
    const size_t kstep = (size_t)(BK * 2);
    const size_t hstepA = (size_t)HALF * g.lda * 2, hstepB = (size_t)HALF * g.ldb * 2;
    const size_t tstepA = 2 * hstepA, tstepB = 2 * hstepB;
    const unsigned ldsw = (unsigned)wid * 1024u;
    const int aoff = lds_byte(wr * 64 + fr, fq * 8), boff = lds_byte(wc * 32 + fr, fq * 8);
#define PG8_SA(b, h) (((b) * 2 + (h)) * HTB)
#define PG8_SB(b, h) ((4 + (b) * 2 + (h)) * HTB)
#define PG8_STAGE(bufoff, gbase, voff) do { _Pragma("unroll") for (int _i = 0; _i < 2; ++_i) \
        __builtin_amdgcn_global_load_lds((const unsigned*)((const char*)(gbase) + (voff)[_i]), (PG8_LAS unsigned*)(lds + (bufoff) + ldsw + _i * 8192), 16, 0, 0); } while (0)
#define PG8_LDA(dst, b, h) do { _Pragma("unroll") for (int m = 0; m < 4; ++m) _Pragma("unroll") for (int k = 0; k < 2; ++k) dst[m][k] = *(const PG8_LAS bf16x8*)(lds + PG8_SA(b, h) + aoff + m * 2048 + k * 1024); } while (0)
#define PG8_LDB(dst, b, h) do { _Pragma("unroll") for (int n = 0; n < 2; ++n) _Pragma("unroll") for (int k = 0; k < 2; ++k) dst[n][k] = *(const PG8_LAS bf16x8*)(lds + PG8_SB(b, h) + boff + n * 2048 + k * 1024); } while (0)
#define PG8_MMA(ai, bj, At, Bt) do { __builtin_amdgcn_s_setprio(1); _Pragma("unroll") for (int m = 0; m < 4; ++m) _Pragma("unroll") for (int n = 0; n < 2; ++n) _Pragma("unroll") for (int k = 0; k < 2; ++k) \
        acc[ai][bj][m][n] = __builtin_amdgcn_mfma_f32_16x16x32_bf16(Bt[n][k], At[m][k], acc[ai][bj][m][n], 0, 0, 0); __builtin_amdgcn_s_setprio(0); } while (0)
#define PG8_WAIT_V(n) asm volatile("s_waitcnt vmcnt(" #n ")" ::: "memory")
#define PG8_WAIT_L(n) asm volatile("s_waitcnt lgkmcnt(" #n ")" ::: "memory")
#define PG8_BAR __builtin_amdgcn_s_barrier()
#define PG8_SCHED __builtin_amdgcn_sched_barrier(0)
    Unit cur, nxt; int ui = 0;
    if (!S.next(0, cur)) return;
    f32x4 acc[2][2][4][2];
#pragma unroll
    for (int a = 0; a < 2; ++a)
#pragma unroll
        for (int b = 0; b < 2; ++b)
#pragma unroll
            for (int m = 0; m < 4; ++m)
#pragma unroll
                for (int n = 0; n < 2; ++n) acc[a][b][m][n] = (f32x4){0.f, 0.f, 0.f, 0.f};
    bf16x8 At[4][2], B0[2][2], B1[2][2];
    const char* cA = (const char*)g.A + (size_t)cur.pm * tstepA; const char* cB = (const char*)g.Bt + (size_t)cur.pn * tstepB;
    S.a_ready(cur);
    if constexpr (SP2) {
        PG8_STAGE(PG8_SB(0, 0), cB, voffB); PG8_STAGE(PG8_SB(0, 1), cB + hstepB, voffB); PG8_STAGE(PG8_SA(0, 0), cA, voffA); PG8_STAGE(PG8_SA(0, 1), cA + hstepA, voffA);
        if (wr == 1) PG8_BAR;
        PG8_WAIT_V(2); PG8_BAR;
        PG8_STAGE(PG8_SB(1, 0), cB + kstep, voffB); PG8_STAGE(PG8_SA(1, 0), cA + kstep, voffA); PG8_STAGE(PG8_SB(1, 1), cB + hstepB + kstep, voffB);
        PG8_WAIT_V(6); PG8_BAR;
    } else {
        PG8_STAGE(PG8_SB(0, 0), cB, voffB); PG8_STAGE(PG8_SA(0, 0), cA, voffA); PG8_STAGE(PG8_SB(0, 1), cB + hstepB, voffB); PG8_STAGE(PG8_SA(0, 1), cA + hstepA, voffA);
        if (wr == 1) PG8_BAR;
        PG8_WAIT_V(4); PG8_BAR;
        PG8_STAGE(PG8_SB(1, 0), cB + kstep, voffB); PG8_STAGE(PG8_SA(1, 0), cA + kstep, voffA); PG8_STAGE(PG8_SB(1, 1), cB + hstepB + kstep, voffB);
        PG8_WAIT_V(6); PG8_BAR;
    }
    for (;;) {
        const bool has_next = S.next(ui + 1, nxt);
        const char* nA = has_next ? (const char*)g.A + (size_t)nxt.pm * tstepA : cA; const char* nB = has_next ? (const char*)g.Bt + (size_t)nxt.pn * tstepB : cB;
        for (int t = 0; t < nt; t += 2) {
            const bool last = (t == nt - 2);
            const char* a1 = cA + (size_t)(t + 1) * kstep;
            const char* a2 = last ? nA : cA + (size_t)(t + 2) * kstep; const char* b2 = last ? nB : cB + (size_t)(t + 2) * kstep;
            const char* a3 = a2 + kstep; const char* b3 = b2 + kstep;
            if (last && has_next) S.a_ready(nxt);
            if constexpr (SP2) {
            PG8_LDB(B0, 0, 0); PG8_LDB(B1, 0, 1); PG8_SCHED; PG8_LDA(At, 0, 0); PG8_STAGE(PG8_SA(1, 1), a1 + hstepA, voffA);
            PG8_WAIT_V(8); PG8_WAIT_L(0); PG8_BAR; PG8_MMA(0, 0, At, B0); PG8_MMA(0, 1, At, B1); PG8_BAR; PG8_SCHED;
            PG8_LDA(At, 0, 1); PG8_STAGE(PG8_SB(0, 0), b2, voffB); PG8_STAGE(PG8_SB(0, 1), b2 + hstepB, voffB); PG8_STAGE(PG8_SA(0, 0), a2, voffA);
            PG8_WAIT_V(8); PG8_WAIT_L(0); PG8_BAR; PG8_MMA(1, 0, At, B0); PG8_MMA(1, 1, At, B1); PG8_BAR; PG8_SCHED;
            PG8_LDB(B0, 1, 0); PG8_LDB(B1, 1, 1); PG8_SCHED; PG8_LDA(At, 1, 0); PG8_STAGE(PG8_SA(0, 1), a2 + hstepA, voffA);
            PG8_WAIT_V(8); PG8_WAIT_L(0); PG8_BAR; PG8_MMA(0, 0, At, B0); PG8_MMA(0, 1, At, B1); PG8_BAR; PG8_SCHED;
            PG8_LDA(At, 1, 1); PG8_STAGE(PG8_SB(1, 0), b3, voffB); PG8_STAGE(PG8_SB(1, 1), b3 + hstepB, voffB); PG8_STAGE(PG8_SA(1, 0), a3, voffA);
            PG8_WAIT_V(8); PG8_WAIT_L(0); PG8_BAR; PG8_MMA(1, 0, At, B0); PG8_MMA(1, 1, At, B1); PG8_BAR; PG8_SCHED;
            } else {
            PG8_LDB(B0, 0, 0); PG8_SCHED; PG8_LDA(At, 0, 0); PG8_STAGE(PG8_SA(1, 1), a1 + hstepA, voffA);
            PG8_WAIT_L(8); PG8_BAR; PG8_WAIT_L(0); PG8_MMA(0, 0, At, B0); PG8_BAR; PG8_SCHED;
            PG8_LDB(B1, 0, 1); PG8_STAGE(PG8_SB(0, 0), b2, voffB);
            PG8_BAR; PG8_WAIT_L(0); PG8_MMA(0, 1, At, B1); PG8_BAR;
            PG8_LDA(At, 0, 1); PG8_STAGE(PG8_SA(0, 0), a2, voffA);
            PG8_BAR; PG8_WAIT_L(0); PG8_MMA(1, 0, At, B0); PG8_BAR; PG8_SCHED;
            PG8_STAGE(PG8_SB(0, 1), b2 + hstepB, voffB);
            PG8_WAIT_V(6); PG8_BAR; PG8_MMA(1, 1, At, B1); PG8_BAR;
            PG8_LDB(B0, 1, 0); PG8_SCHED; PG8_LDA(At, 1, 0); PG8_STAGE(PG8_SA(0, 1), a2 + hstepA, voffA);
            PG8_WAIT_L(8); PG8_BAR; PG8_WAIT_L(0); PG8_MMA(0, 0, At, B0); PG8_BAR; PG8_SCHED;
            PG8_LDB(B1, 1, 1); PG8_STAGE(PG8_SB(1, 0), b3, voffB);
            PG8_BAR; PG8_WAIT_L(0); PG8_MMA(0, 1, At, B1); PG8_BAR;
            PG8_LDA(At, 1, 1); PG8_STAGE(PG8_SA(1, 0), a3, voffA);
            PG8_BAR; PG8_WAIT_L(0); PG8_MMA(1, 0, At, B0); PG8_BAR; PG8_SCHED;
            PG8_STAGE(PG8_SB(1, 1), b3 + hstepB, voffB);
            PG8_WAIT_V(6); PG8_BAR; PG8_MMA(1, 1, At, B1); PG8_BAR;
            }
        }
        if constexpr (ALIGN_EPI) { if (wr == 0) PG8_BAR; }
        if constexpr (!Epi::AFTER_DRAIN) { E(acc, cur, wr, wc, fr, fq); S.done(cur); }
        if (!has_next) break;
#pragma unroll
        for (int a = 0; a < 2; ++a)
#pragma unroll
            for (int b = 0; b < 2; ++b)
#pragma unroll
                for (int m = 0; m < 4; ++m)
#pragma unroll
                    for (int n = 0; n < 2; ++n) acc[a][b][m][n] = (f32x4){0.f, 0.f, 0.f, 0.f};
        cur = nxt; cA = nA; cB = nB; ++ui;
        if constexpr (ALIGN_EPI) { if (wr == 1) PG8_BAR; }
    }
    PG8_WAIT_V(0);
    if constexpr (!ALIGN_EPI) { if (wr == 0) PG8_BAR; }
    PG8_BAR;
    if constexpr (Epi::AFTER_DRAIN) { E.fused(acc, cur, wr, wc, fr, fq, lds, wid, lane); S.done(cur); }
#undef PG8_SA
#undef PG8_SB
#undef PG8_STAGE
#undef PG8_LDA
#undef PG8_LDB
#undef PG8_MMA
#undef PG8_WAIT_V
#undef PG8_WAIT_L
#undef PG8_BAR
#undef PG8_SCHED
}
}

constexpr int NWAVES = 8;
constexpr int BATCH = 8, SEQ = 2048, DM = 1024, M = BATCH * SEQ;
constexpr int N1 = 3072;
constexpr int N1SRC = 2856;
constexpr int Y1_QA = 0, Y1_KA = 512, Y1_VA = 1024, Y1_CQ = 1536, Y1_KIDX = 1792, Y1_WIDX = 1824, Y1_GATE = 2048;
constexpr int N2 = 2048;
constexpr int QL_QIDX = 1024, QL_KV = 1280, QL_VP = 1408;
constexpr int N3 = 2816;
constexpr int Y2_KC = 512, Y2_VC = 640, Y2_DVAL = 768, Y2_DGATE = 1280, Y2_GATE = 1792;
constexpr float EPS = 1e-6f, LOG2E = 1.4426950408889634f;
constexpr float CQK = 0.125f * LOG2E;
constexpr float CQL = 0.08838834764831845f * LOG2E;
constexpr float LAM_INIT = 0.2f;
constexpr int TOPK = 256;

constexpr size_t MiB = 1u << 20;
constexpr size_t WS_CTL = 0, CTL_ZERO_BYTES = 1 * MiB;
constexpr size_t WS_STATS = 512 * 1024;
constexpr size_t WS_MODS = 1 * MiB;
constexpr size_t WS_W1T = 2 * MiB;
constexpr size_t WS_WO1T = 8 * MiB;
constexpr size_t WS_W3T = 10 * MiB;
constexpr size_t WS_WO2T = 16 * MiB;
constexpr size_t WS_W2T = 18 * MiB;
constexpr size_t WS_XN = 20 * MiB;
constexpr size_t WS_Y1 = 52 * MiB;
constexpr size_t WS_QL = 148 * MiB;
constexpr size_t WS_YC = 212 * MiB;
constexpr size_t WS_MASK = 244 * MiB;
constexpr size_t WS_END = 248 * MiB;
constexpr int CW_BAR = 4096;

constexpr int RING_OFF = 0, RING_BYTES = 131072;
constexpr int LDSCTL_OFF = RING_BYTES, MISC_OFF = LDSCTL_OFF + 320;
constexpr int LDS_BYTES = 147456;

#define GAS __attribute__((address_space(1)))
#define LAS __attribute__((address_space(3)))
typedef unsigned short bf16;
typedef unsigned v4u __attribute__((ext_vector_type(4)));
typedef float f32x4 __attribute__((ext_vector_type(4)));
typedef short bf16x8 __attribute__((ext_vector_type(8)));
typedef GAS unsigned gu32;
typedef GAS unsigned long long gu64;
#define RLX_AGENT __ATOMIC_RELAXED, __HIP_MEMORY_SCOPE_AGENT
#define LDS_WAIT() asm volatile("s_waitcnt lgkmcnt(0)" ::: "memory")
#define VM_WAIT() asm volatile("s_waitcnt vmcnt(0)" ::: "memory")
__device__ __forceinline__ unsigned long long rt() { return __builtin_amdgcn_s_memrealtime(); }
__device__ __forceinline__ unsigned f2bf(float f) { unsigned u = __builtin_bit_cast(unsigned, f); return (u + 0x7fffu + ((u >> 16) & 1u)) >> 16; }
__device__ __forceinline__ unsigned pk2(float lo, float hi) { return f2bf(lo) | (f2bf(hi) << 16); }

#define XB_TMO      128
#define XB_XCNT(j)  (256  + 64 * (j))
#define XB_XSUB(j)  (1280 + 64 * (j))
#define XB_XGEN(j)  (2304 + 64 * (j))
#define XB_TOP      3328
#define XB_TOPGEN   3392
#define XCD_BAR_WORDS 3456
#define XB_SPIN_CAP (1u << 18)

__device__ __forceinline__ unsigned xb_ld(unsigned* p)              { return __hip_atomic_load(p, __ATOMIC_RELAXED, __HIP_MEMORY_SCOPE_AGENT); }
__device__ __forceinline__ unsigned xb_add(unsigned* p, unsigned v) { return __hip_atomic_fetch_add(p, v, __ATOMIC_RELAXED, __HIP_MEMORY_SCOPE_AGENT); }
__device__ __forceinline__ unsigned xb_xcc_id() { return (unsigned)__builtin_amdgcn_s_getreg((3 << 11) | 20) & 0xFu; }
#define XB_SPIN(cond, bar) do { unsigned _sp = 0; while (cond) { __builtin_amdgcn_s_sleep(1); \
    if ((++_sp & 255u) == 0u) { if (xb_ld(&(bar)[XB_TMO])) break; if (_sp > XB_SPIN_CAP) { atomicAdd(&(bar)[XB_TMO], 1u); break; } } } } while (0)

struct XcdBarrier {
    unsigned* bar; unsigned x;
    volatile LAS unsigned* st;
};

__device__ __forceinline__ XcdBarrier xcd_barrier_post(unsigned* bar, volatile LAS unsigned* st) {
    XcdBarrier b; b.bar = bar; b.x = xb_xcc_id(); b.st = st;
    if (threadIdx.x == 0) (void)xb_add(&bar[XB_XCNT(b.x)], 1u);
    return b;
}
__device__ __forceinline__ void xcd_barrier_complete(unsigned* bar, unsigned x, unsigned& nloc, unsigned& nx) {
    const unsigned G = gridDim.x * gridDim.y * gridDim.z;
    unsigned sum, cnt, mine, sp = 0u;
    for (;;) {
        sum = 0u; cnt = 0u; mine = 0u;
#pragma unroll
        for (unsigned j = 0; j < 16; ++j) { const unsigned c = xb_ld(&bar[XB_XCNT(j)]); sum += c; cnt += (c > 0u) ? 1u : 0u; mine = (j == x) ? c : mine; }
        if (sum == G) break;
        __builtin_amdgcn_s_sleep(1);
        if ((++sp & 255u) == 0u) { if (xb_ld(&bar[XB_TMO])) break; if (sp > XB_SPIN_CAP) { atomicAdd(&bar[XB_TMO], 1u); break; } }
    }
    nloc = mine > 0u ? mine : 1u; nx = cnt > 0u ? cnt : 1u;
}

__device__ __forceinline__ void xcd_barrier(const XcdBarrier& b) {
    asm volatile("s_waitcnt vmcnt(0)" ::: "memory");
    __syncthreads();
    if (threadIdx.x == 0) {
        unsigned* bar = b.bar;
        __builtin_amdgcn_s_waitcnt(0);
        unsigned nloc = b.st[0], nx = b.st[1];
        if (nloc == 0u) { xcd_barrier_complete(bar, b.x, nloc, nx); b.st[0] = nloc; b.st[1] = nx; }
        const unsigned old = xb_add(&bar[XB_XSUB(b.x)], 1u);
        const unsigned gen = old / nloc;
        if (old + 1u == (gen + 1u) * nloc) {
            __builtin_amdgcn_fence(__ATOMIC_RELEASE, "agent");
            asm volatile("s_waitcnt vmcnt(0)" ::: "memory");
            const unsigned og = xb_add(&bar[XB_TOP], 1u);
            const unsigned tg = og / nx;
            if (og + 1u == (tg + 1u) * nx) xb_add(&bar[XB_TOPGEN], 1u);
            else XB_SPIN(xb_ld(&bar[XB_TOPGEN]) == tg, bar);
            __builtin_amdgcn_fence(__ATOMIC_ACQUIRE, "agent");
            xb_add(&bar[XB_XGEN(b.x)], 1u);
            asm volatile("s_waitcnt vmcnt(0)" ::: "memory");
        } else {
            XB_SPIN(xb_ld(&bar[XB_XGEN(b.x)]) == gen, bar);
            __builtin_amdgcn_fence(__ATOMIC_ACQUIRE, "agent");
            asm volatile("s_waitcnt vmcnt(0)" ::: "memory");
        }
    }
    __syncthreads();
}


struct Frame {
    LAS unsigned char* lds;
    volatile LAS unsigned* MISC;
    gu32* ctl;
    int tid, lane, wave;
    int vcu, G;
};
__device__ __forceinline__ float wave_sum(float v) {
#pragma unroll
    for (int o = 1; o < 64; o <<= 1) v += __shfl_xor(v, o);
    return v;
}
__device__ __forceinline__ float wave_max(float v) {
#pragma unroll
    for (int o = 1; o < 64; o <<= 1) v = fmaxf(v, __shfl_xor(v, o));
    return v;
}
__device__ __forceinline__ float bflo(unsigned w) { return __uint_as_float(w << 16); }
__device__ __forceinline__ float bfhi(unsigned w) { return __uint_as_float(w & 0xffff0000u); }
__device__ __forceinline__ float bf2f(bf16 u) { return __uint_as_float((unsigned)u << 16); }
__device__ __forceinline__ float silu_f(float g) { return g / (1.0f + __expf(-g)); }

template <int KIND> __device__ __forceinline__ int map_col(int d, float& sc) {
    sc = 1.0f;
    if (KIND == 0) { if (d < 512) sc = CQK; if (d < 1832) return d; if (d < 2048) return -1; return d - 216; }
    if (KIND == 2) { if (d < 512) sc = CQK; return d; }
    return d;
}
template <int KIND> __device__ __forceinline__ void p0_transpose_item(const float* W, int K, int Nsrc, int Ndst, bf16* WT, LAS float* scr, int item, int lane) {
    const int nblk = Ndst / 32, kb = item / nblk, nb = item % nblk, k0 = 64 * kb, n0 = 32 * nb;
    float sc; const int src = map_col<KIND>(n0 + (lane & 31), sc);
#pragma unroll 8
    for (int i = 0; i < 32; ++i) { const int kk = 2 * i + (lane >> 5); scr[kk * 33 + (lane & 31)] = (src >= 0) ? W[(size_t)(k0 + kk) * Nsrc + src] * sc : 0.0f; }
    LDS_WAIT(); asm volatile("" ::: "memory");
    const int c = lane & 7;
#pragma unroll
    for (int j = 0; j < 4; ++j) { const int n = (lane >> 3) + 8 * j; const LAS float* s = scr + (8 * c) * 33 + n;
        v4u o; o.x = pk2(s[0 * 33], s[1 * 33]); o.y = pk2(s[2 * 33], s[3 * 33]); o.z = pk2(s[4 * 33], s[5 * 33]); o.w = pk2(s[6 * 33], s[7 * 33]);
        *(GAS v4u*)(WT + (size_t)(n0 + n) * K + k0 + 8 * c) = o; }
    LDS_WAIT(); asm volatile("" ::: "memory");
}
struct Ptrs {
    const float* in[25]; float* out; unsigned char* ws;
};
__device__ __forceinline__ void p0_prologue(Frame& F, const Ptrs& P) {
    LAS float* scr = (LAS float*)(F.lds + RING_OFF + F.wave * 16384);
    const int gw = F.vcu * NWAVES + F.wave, NGW = F.G * NWAVES;
    bf16* W1T = (bf16*)(P.ws + WS_W1T); bf16* WO1T = (bf16*)(P.ws + WS_WO1T); bf16* W3T = (bf16*)(P.ws + WS_W3T); bf16* WO2T = (bf16*)(P.ws + WS_WO2T); bf16* W2T = (bf16*)(P.ws + WS_W2T);
    constexpr int I_1 = 16 * (N1 / 32), I_O = 16 * 32, I_3 = 16 * (N3 / 32);
    constexpr int NITEMS = I_1 + I_O + I_3 + I_O;
    for (int it = gw; it < NITEMS; it += NGW) {
        int r = it;
        if (r < I_1) { p0_transpose_item<0>(P.in[5], 1024, N1SRC, N1, W1T, scr, r, F.lane); continue; } r -= I_1;
        if (r < I_O) { p0_transpose_item<1>(P.in[16], 1024, 1024, 1024, WO1T, scr, r, F.lane); continue; } r -= I_O;
        if (r < I_3) { p0_transpose_item<2>(P.in[17], 1024, N3, N3, W3T, scr, r, F.lane); continue; } r -= I_3;
        p0_transpose_item<1>(P.in[23], 1024, 1024, 1024, WO2T, scr, r, F.lane);
    }
    {
        const float* gq = P.in[6]; const float* gkv = P.in[7]; const float* wuq = P.in[8]; const float* wqi = P.in[9]; const float* wuv = P.in[10];
        for (int e = (int)blockIdx.x * 512 + F.tid; e < N2 * 256; e += F.G * 512) {
            const int n = e >> 8, k = e & 255; float v = 0.0f;
            if (n < 1024) { if (k < 128) v = gq[k] * wuq[(size_t)(k * 8 + (n >> 7)) * 128 + (n & 127)] * CQL; }
            else if (n < 1280) { const int j = n - 1024; if (k < 128) v = gq[k] * wqi[(size_t)(k * 8 + (j >> 5)) * 32 + (j & 31)]; }
            else if (n < 1408) { const int j = n - 1280; if (k == 128 + j) v = gkv[j]; }
            else if (n < 1920) { const int j = n - 1408; if (k >= 128) v = gkv[k - 128] * wuv[(size_t)((j >> 6) * 128 + (k - 128)) * 64 + (j & 63)]; }
            W2T[e] = (bf16)f2bf(v);
        }
    }
    __syncthreads();
    {
        LAS float* sl = (LAS float*)(F.lds + RING_OFF);
        LAS float* red = sl + 8192;
        const float* c = P.in[1]; const float* adaw = P.in[2]; const float* adab = P.in[3]; float* mods = (float*)(P.ws + WS_MODS);
        bool loaded = false;
        for (int it = (int)blockIdx.x; it < 96; it += F.G) {
            if (!loaded) { for (int i = F.tid; i < 8192; i += 512) sl[i] = silu_f(c[i]); loaded = true; __syncthreads(); }
            const int l = it / 48, n0 = (it % 48) * 64, col = F.tid & 63, kg = F.tid >> 6;
            float acc[8];
#pragma unroll
            for (int b = 0; b < 8; ++b) acc[b] = 0.0f;
            const float* wp = adaw + ((size_t)l * 1024 + kg * 128) * 3072 + n0 + col;
            for (int k = 0; k < 128; ++k) { const float w = wp[(size_t)k * 3072];
#pragma unroll
                for (int b = 0; b < 8; ++b) acc[b] += sl[b * 1024 + kg * 128 + k] * w; }
#pragma unroll
            for (int b = 0; b < 8; ++b) red[(kg * 8 + b) * 64 + col] = acc[b];
            __syncthreads();
            { const int b = F.tid >> 6; float s = 0.0f;
#pragma unroll
              for (int g2 = 0; g2 < 8; ++g2) s += red[(g2 * 8 + b) * 64 + col];
              mods[((size_t)l * 8 + b) * 3072 + n0 + col] = s + adab[l * 3072 + n0 + col]; }
            __syncthreads();
        }
    }
}

__device__ __forceinline__ void xn_phase(Frame& F, const float* xin, const float* g, const float* mods_l, bf16* XN) {
    const int gw = F.vcu * NWAVES + F.wave, NGW = F.G * NWAVES;
    for (int m = gw; m < M; m += NGW) {
        const int b = m >> 11;
        const GAS f32x4* xr = (const GAS f32x4*)(xin + (size_t)m * DM) + F.lane;
        f32x4 v[4]; float s = 0.f;
#pragma unroll
        for (int j = 0; j < 4; ++j) { v[j] = xr[64 * j]; s += (v[j].x * v[j].x + v[j].y * v[j].y) + (v[j].z * v[j].z + v[j].w * v[j].w); }
        const float rstd = 1.0f / sqrtf(wave_sum(s) * (1.0f / DM) + EPS);
        GAS unsigned long long* o8 = (GAS unsigned long long*)(XN + (size_t)m * DM) + F.lane;
#pragma unroll
        for (int j = 0; j < 4; ++j) { const int col = 4 * F.lane + 256 * j;
            const f32x4 gv = *(const f32x4*)(g + col), sc = *(const f32x4*)(mods_l + (size_t)b * 3072 + 1024 + col), sh = *(const f32x4*)(mods_l + (size_t)b * 3072 + col);
            const f32x4 h = v[j] * rstd * gv * (sc + 1.0f) + sh;
            o8[64 * j] = (unsigned long long)pk2(h.x, h.y) | ((unsigned long long)pk2(h.z, h.w) << 32); }
    }
}
__device__ __forceinline__ void final_norm_phase(Frame& F, float* x, const float* g) {
    const int gw = F.vcu * NWAVES + F.wave, NGW = F.G * NWAVES;
    for (int m = gw; m < M; m += NGW) {
        GAS f32x4* xr = (GAS f32x4*)(x + (size_t)m * DM) + F.lane;
        f32x4 v[4]; float s = 0.f;
#pragma unroll
        for (int j = 0; j < 4; ++j) { v[j] = xr[64 * j]; s += (v[j].x * v[j].x + v[j].y * v[j].y) + (v[j].z * v[j].z + v[j].w * v[j].w); }
        const float rstd = 1.0f / sqrtf(wave_sum(s) * (1.0f / DM) + EPS);
#pragma unroll
        for (int j = 0; j < 4; ++j) { const f32x4 gv = *(const f32x4*)(g + 4 * F.lane + 256 * j); xr[64 * j] = v[j] * rstd * gv; }
    }
}

__device__ __forceinline__ unsigned long long lowest_n_bits(unsigned long long e, int n) {
    unsigned long long r = 0ull;
    while (n > 0 && e) { const unsigned long long b = e & (0ull - e); r |= b; e ^= b; --n; }
    return r;
}
__device__ __forceinline__ unsigned long long topk_select(const unsigned (&keyv)[32], int lane) {
    unsigned T = 0u;
    for (int bit = 31; bit >= 0; --bit) {
        const unsigned cand = T | (1u << bit); int cnt = 0;
#pragma unroll
        for (int i = 0; i < 32; ++i) cnt += __popcll(__ballot(keyv[i] >= cand));
        if (cnt >= TOPK) T = cand;
    }
    int cgt = 0;
#pragma unroll
    for (int i = 0; i < 32; ++i) cgt += __popcll(__ballot(keyv[i] > T));
    int need = TOPK - cgt;
    unsigned long long mine = 0ull;
#pragma unroll
    for (int i = 0; i < 32; ++i) {
        const unsigned long long g = __ballot(keyv[i] > T), e = __ballot(keyv[i] == T);
        const int ne = __popcll(e);
        unsigned long long take;
        if (ne <= need) { take = e; need -= ne; } else { take = lowest_n_bits(e, need); need = 0; }
        const unsigned long long word = g | take;
        mine = (lane == i) ? word : mine;
    }
    return mine;
}
__device__ __forceinline__ unsigned sort_key(float v) { const unsigned u = __float_as_uint(v); return (u & 0x80000000u) ? ~u : (u | 0x80000000u); }

__device__ __forceinline__ void indexer_naive(Frame& F, const bf16* Y1, const bf16* QL, unsigned long long* MASK) {
    const int gw = F.vcu * NWAVES + F.wave, NGW = F.G * NWAVES, lane = F.lane;
    LAS float* qs = (LAS float*)(F.lds + RING_OFF + F.wave * 9216);
    LAS float* sc = qs + 256;
    for (int row = gw; row < M; row += NGW) {
        const int b = row >> 11, q = row & 2047;
        { const uint2 w2 = *(const uint2*)(QL + (size_t)row * N2 + QL_QIDX + 4 * lane);
          qs[4 * lane + 0] = bflo(w2.x); qs[4 * lane + 1] = bfhi(w2.x); qs[4 * lane + 2] = bflo(w2.y); qs[4 * lane + 3] = bfhi(w2.y); }
        float w[8];
        { const uint4 wv = *(const uint4*)(Y1 + (size_t)row * N1 + Y1_WIDX);
          w[0] = bflo(wv.x); w[1] = bfhi(wv.x); w[2] = bflo(wv.y); w[3] = bfhi(wv.y); w[4] = bflo(wv.z); w[5] = bfhi(wv.z); w[6] = bflo(wv.w); w[7] = bfhi(wv.w); }
        LDS_WAIT(); asm volatile("" ::: "memory");
        const int nw = (q >> 6) + 1;
        unsigned long long mine = 0ull;
        if (q + 1 <= TOPK) {
#pragma unroll
            for (int i = 0; i < 32; ++i) { const unsigned long long word = __ballot(64 * i + lane <= q); mine = (lane == i) ? word : mine; }
        } else {
            for (int i = 0; i < nw; ++i) {
                const int key = 64 * i + lane; float s = -INFINITY;
                if (key <= q) {
                    const uint4* kp = (const uint4*)(Y1 + (size_t)(b * SEQ + key) * N1 + Y1_KIDX);
                    float k[32];
#pragma unroll
                    for (int j = 0; j < 4; ++j) { const uint4 kv = kp[j];
                        k[8 * j + 0] = bflo(kv.x); k[8 * j + 1] = bfhi(kv.x); k[8 * j + 2] = bflo(kv.y); k[8 * j + 3] = bfhi(kv.y);
                        k[8 * j + 4] = bflo(kv.z); k[8 * j + 5] = bfhi(kv.z); k[8 * j + 6] = bflo(kv.w); k[8 * j + 7] = bfhi(kv.w); }
                    float acc = 0.0f;
#pragma unroll
                    for (int h = 0; h < 8; ++h) { float d = 0.0f;
#pragma unroll
                        for (int t = 0; t < 32; ++t) d += k[t] * qs[h * 32 + t];
                        acc += w[h] * fmaxf(d, 0.0f); }
                    s = acc + 0.0f;
                }
                sc[key] = s;
            }
            LDS_WAIT(); asm volatile("" ::: "memory");
            unsigned keyv[32];
#pragma unroll
            for (int i = 0; i < 32; ++i) { const float v = (i < nw) ? sc[64 * i + lane] : -INFINITY; keyv[i] = sort_key(v); }
            mine = topk_select(keyv, lane);
        }
        if (lane < 32) MASK[(size_t)row * 32 + lane] = mine;
        LDS_WAIT(); asm volatile("" ::: "memory");
    }
}

__device__ __forceinline__ void diffattn_naive(Frame& F, const Ptrs& P, const bf16* Y1, bf16* YC) {
    const int gw = F.vcu * NWAVES + F.wave, NGW = F.G * NWAVES, lane = F.lane, l5 = lane & 31;
    const float lam = __expf(wave_sum(P.in[11][lane] * P.in[12][lane])) - __expf(wave_sum(P.in[13][lane] * P.in[14][lane])) + LAM_INIT;
    const float* subg = P.in[15];
    for (int task = gw; task < M * 4; task += NGW) {
        const int row = task >> 2, h = task & 3, b = row >> 11, q = row & 2047;
        const unsigned qv = *(const unsigned*)(Y1 + (size_t)row * N1 + Y1_QA + 128 * h + 2 * lane);
        const float q0 = bflo(qv), q1 = bfhi(qv);
        const float slope2 = exp2f(-2.0f * (float)(h + 1)) * LOG2E;
        float m = -1e30f, l = 0.0f, o[4] = {0.f, 0.f, 0.f, 0.f};
        const bf16* Kb = Y1 + (size_t)(b * SEQ) * N1 + Y1_KA + 128 * h + 2 * lane;
        const bf16* Vb = Y1 + (size_t)(b * SEQ) * N1 + Y1_VA + 128 * h + 4 * l5;
        for (int k0 = 0; k0 <= q; k0 += 4) {
            unsigned kk[4]; uint2 vv[4];
#pragma unroll
            for (int j = 0; j < 4; ++j) { const int k = min(k0 + j, q); kk[j] = *(const unsigned*)(Kb + (size_t)k * N1); vv[j] = *(const uint2*)(Vb + (size_t)k * N1); }
#pragma unroll
            for (int j = 0; j < 4; ++j) {
                const int k = k0 + j;
                float part = q0 * bflo(kk[j]) + q1 * bfhi(kk[j]);
                part += __shfl_xor(part, 1); part += __shfl_xor(part, 2); part += __shfl_xor(part, 4); part += __shfl_xor(part, 8); part += __shfl_xor(part, 16);
                if (k <= q) {
                    const float s = part - slope2 * (float)(q - k);
                    const float mn = fmaxf(m, s), alpha = exp2f(m - mn), p = exp2f(s - mn);
                    l = l * alpha + p;
                    o[0] = o[0] * alpha + p * bflo(vv[j].x); o[1] = o[1] * alpha + p * bfhi(vv[j].x); o[2] = o[2] * alpha + p * bflo(vv[j].y); o[3] = o[3] * alpha + p * bfhi(vv[j].y);
                    m = mn;
                }
            }
        }
        const float il = 1.0f / l;
        float d[4]; float ss = 0.0f;
#pragma unroll
        for (int i = 0; i < 4; ++i) { const float mine = o[i] * il, other = __shfl_xor(mine, 32); d[i] = mine - lam * other; ss += d[i] * d[i]; }
        ss += __shfl_xor(ss, 1); ss += __shfl_xor(ss, 2); ss += __shfl_xor(ss, 4); ss += __shfl_xor(ss, 8); ss += __shfl_xor(ss, 16);
        const float rs = 1.0f / sqrtf(ss * (1.0f / 128.0f) + EPS) * (1.0f - LAM_INIT);
        if (lane < 32) {
            const uint2 gv = *(const uint2*)(Y1 + (size_t)row * N1 + Y1_GATE + 128 * h + 4 * l5);
            const float g0 = bflo(gv.x), g1 = bfhi(gv.x), g2 = bflo(gv.y), g3 = bfhi(gv.y);
            const float y0 = d[0] * rs * subg[4 * l5 + 0] * silu_f(g0), y1 = d[1] * rs * subg[4 * l5 + 1] * silu_f(g1), y2 = d[2] * rs * subg[4 * l5 + 2] * silu_f(g2), y3 = d[3] * rs * subg[4 * l5 + 3] * silu_f(g3);
            *(uint2*)(YC + (size_t)row * DM + 128 * h + 4 * l5) = make_uint2(pk2(y0, y1), pk2(y2, y3));
        }
    }
}

__device__ __forceinline__ void dsa_naive(Frame& F, const bf16* Y1, const bf16* QL, const unsigned long long* MASK, bf16* YC) {
    const int gw = F.vcu * NWAVES + F.wave, NGW = F.G * NWAVES, lane = F.lane, h = lane >> 3, j = lane & 7;
    const float slope2 = exp2f(-(float)(h + 1)) * LOG2E;
    for (int row = gw; row < M; row += NGW) {
        const int b = row >> 11, q = row & 2047;
        float qf[16];
        { const uint4* qp = (const uint4*)(QL + (size_t)row * N2 + 128 * h + 16 * j);
#pragma unroll
          for (int t = 0; t < 2; ++t) { const uint4 v = qp[t]; qf[8 * t + 0] = bflo(v.x); qf[8 * t + 1] = bfhi(v.x); qf[8 * t + 2] = bflo(v.y); qf[8 * t + 3] = bfhi(v.y); qf[8 * t + 4] = bflo(v.z); qf[8 * t + 5] = bfhi(v.z); qf[8 * t + 6] = bflo(v.w); qf[8 * t + 7] = bfhi(v.w); } }
        float m = -1e30f, l = 0.0f, o[8];
#pragma unroll
        for (int i = 0; i < 8; ++i) o[i] = 0.0f;
        const int nw = (q >> 6) + 1;
        for (int t = 0; t < nw; ++t) {
            const unsigned long long wraw = MASK[(size_t)row * 32 + t];
            unsigned long long w = ((unsigned long long)(unsigned)__builtin_amdgcn_readfirstlane((int)(wraw >> 32)) << 32) | (unsigned)__builtin_amdgcn_readfirstlane((int)(unsigned)wraw);
            while (w) {
                const int bit = __builtin_ctzll(w); w &= w - 1ull;
                const int k = 64 * t + bit; const bf16* kr = QL + (size_t)(b * SEQ + k) * N2;
                const uint4 ka = *(const uint4*)(kr + QL_KV + 16 * j), kb = *(const uint4*)(kr + QL_KV + 16 * j + 8);
                const uint4 vp = *(const uint4*)(kr + QL_VP + 64 * h + 8 * j);
                float part = qf[0] * bflo(ka.x) + qf[1] * bfhi(ka.x) + qf[2] * bflo(ka.y) + qf[3] * bfhi(ka.y) + qf[4] * bflo(ka.z) + qf[5] * bfhi(ka.z) + qf[6] * bflo(ka.w) + qf[7] * bfhi(ka.w)
                           + qf[8] * bflo(kb.x) + qf[9] * bfhi(kb.x) + qf[10] * bflo(kb.y) + qf[11] * bfhi(kb.y) + qf[12] * bflo(kb.z) + qf[13] * bfhi(kb.z) + qf[14] * bflo(kb.w) + qf[15] * bfhi(kb.w);
                part += __shfl_xor(part, 1); part += __shfl_xor(part, 2); part += __shfl_xor(part, 4);
                const float s = part - slope2 * (float)(q - k);
                const float mn = fmaxf(m, s), alpha = exp2f(m - mn), p = exp2f(s - mn);
                l = l * alpha + p; m = mn;
                o[0] = o[0] * alpha + p * bflo(vp.x); o[1] = o[1] * alpha + p * bfhi(vp.x); o[2] = o[2] * alpha + p * bflo(vp.y); o[3] = o[3] * alpha + p * bfhi(vp.y);
                o[4] = o[4] * alpha + p * bflo(vp.z); o[5] = o[5] * alpha + p * bfhi(vp.z); o[6] = o[6] * alpha + p * bflo(vp.w); o[7] = o[7] * alpha + p * bfhi(vp.w);
            }
        }
        const float il = 1.0f / l;
        const uint4 gv = *(const uint4*)(Y1 + (size_t)row * N1 + Y1_GATE + 512 + 64 * h + 8 * j);
        const float g[8] = {bflo(gv.x), bfhi(gv.x), bflo(gv.y), bfhi(gv.y), bflo(gv.z), bfhi(gv.z), bflo(gv.w), bfhi(gv.w)};
        float y[8];
#pragma unroll
        for (int i = 0; i < 8; ++i) y[i] = o[i] * il * silu_f(g[i]);
        *(uint4*)(YC + (size_t)row * DM + 512 + 64 * h + 8 * j) = make_uint4(pk2(y[0], y[1]), pk2(y[2], y[3]), pk2(y[4], y[5]), pk2(y[6], y[7]));
    }
}

__device__ __forceinline__ void swa_naive(Frame& F, const Ptrs& P, const bf16* Y2, bf16* YC) {
    const int gw = F.vcu * NWAVES + F.wave, NGW = F.G * NWAVES, lane = F.lane;
    LAS float* qs = (LAS float*)(F.lds + RING_OFF + F.wave * 1024);
    const float* sinks = P.in[18];
    for (int task = gw; task < M * 8; task += NGW) {
        const int row = task >> 3, head = task & 7, g = head >> 2, b = row >> 11, q = row & 2047;
        qs[lane] = bf2f(Y2[(size_t)row * N3 + 64 * head + lane]);
        LDS_WAIT(); asm volatile("" ::: "memory");
        const float slope2 = exp2f(-(float)(head + 1)) * LOG2E, sink2 = sinks[head] * LOG2E;
        float s2[2];
#pragma unroll
        for (int ds = 0; ds < 2; ++ds) {
            const int dist = lane + 64 * ds, k = q - dist; float s = -INFINITY;
            if (k >= 0) {
                const uint4* kp = (const uint4*)(Y2 + (size_t)(b * SEQ + k) * N3 + Y2_KC + 64 * g);
                float dot = 0.0f;
#pragma unroll
                for (int t = 0; t < 8; ++t) { const uint4 kv = kp[t];
                    dot += qs[8 * t + 0] * bflo(kv.x) + qs[8 * t + 1] * bfhi(kv.x) + qs[8 * t + 2] * bflo(kv.y) + qs[8 * t + 3] * bfhi(kv.y)
                         + qs[8 * t + 4] * bflo(kv.z) + qs[8 * t + 5] * bfhi(kv.z) + qs[8 * t + 6] * bflo(kv.w) + qs[8 * t + 7] * bfhi(kv.w); }
                s = dot - slope2 * (float)dist;
            }
            s2[ds] = s;
        }
        const float m = fmaxf(wave_max(fmaxf(s2[0], s2[1])), sink2);
        const float p0 = exp2f(s2[0] - m), p1 = exp2f(s2[1] - m);
        const float denom = wave_sum(p0 + p1) + exp2f(sink2 - m);
        float acc = 0.0f;
        const int nd = min(127, q);
        const bf16* vb = Y2 + (size_t)(b * SEQ) * N3 + Y2_VC + 64 * g + lane;
        for (int dist = 0; dist <= nd; ++dist) {
            const float p = (dist < 64) ? __shfl(p0, dist) : __shfl(p1, dist - 64);
            acc += p * bf2f(vb[(size_t)(q - dist) * N3]);
        }
        const float gt = bf2f(Y2[(size_t)row * N3 + Y2_GATE + 64 * head + lane]);
        YC[(size_t)row * DM + 64 * head + lane] = (bf16)f2bf(acc / denom * silu_f(gt));
        LDS_WAIT(); asm volatile("" ::: "memory");
    }
}

__device__ __forceinline__ void conv_phase(Frame& F, const Ptrs& P, const bf16* Y2, bf16* YC) {
    LAS float* CO = (LAS float*)(F.lds + RING_OFF);
    const float* dww = P.in[19]; const float* dwb = P.in[20]; const float* lng = P.in[21]; const float* lnb = P.in[22];
    const int c = F.tid;
    float wt[31];
#pragma unroll
    for (int j = 0; j < 31; ++j) wt[j] = dww[j * 512 + c];
    const float bias = dwb[c];
    for (int u = F.vcu; u < BATCH * 64; u += F.G) {
        const int b = u >> 6, t0 = (u & 63) * 32;
        float h[62];
#pragma unroll
        for (int r = 0; r < 62; ++r) { const int pos = t0 - 30 + r; float v = 0.0f;
            if (pos >= 0) { const bf16* rp = Y2 + (size_t)(b * SEQ + pos) * N3; const float val = bf2f(rp[Y2_DVAL + c]), gt = bf2f(rp[Y2_DGATE + c]); v = val / (1.0f + __expf(-gt)); }
            h[r] = v; }
#pragma unroll
        for (int t = 0; t < 32; ++t) { float a = bias;
#pragma unroll
            for (int j = 0; j < 31; ++j) a += wt[j] * h[t + j];
            CO[t * 512 + c] = a; }
        __syncthreads();
#pragma unroll
        for (int tt = 0; tt < 4; ++tt) { const int t = F.wave * 4 + tt, row = b * SEQ + t0 + t;
            float v[8]; float s = 0.0f;
#pragma unroll
            for (int i = 0; i < 8; ++i) { v[i] = CO[t * 512 + F.lane + 64 * i]; s += v[i]; }
            const float mu = wave_sum(s) * (1.0f / 512.0f); float s2 = 0.0f;
#pragma unroll
            for (int i = 0; i < 8; ++i) { v[i] -= mu; s2 += v[i] * v[i]; }
            const float rstd = 1.0f / sqrtf(wave_sum(s2) * (1.0f / 512.0f) + EPS);
#pragma unroll
            for (int i = 0; i < 8; ++i) { const int ch = F.lane + 64 * i; const float y = v[i] * rstd * lng[ch] + lnb[ch];
                const float gt = bf2f(Y2[(size_t)row * N3 + Y2_GATE + 512 + ch]);
                YC[(size_t)row * DM + 512 + ch] = (bf16)f2bf(silu_f(y) * silu_f(gt)); } }
        __syncthreads();
    }
}

#ifndef MK_PER_PHASE
#define MK_PER_PHASE 1
#endif
constexpr int N_PHASES = 12;
struct Args { const float* in[25]; float* out; unsigned char* ws; int ph_lo, ph_hi; };
static_assert(sizeof(Args) == 25 * 8 + 8 + 8 + 8, "Args has no padding");

__global__ void __launch_bounds__(NWAVES * 64, 2) mega_fwd(Args args) {
    extern __shared__ __attribute__((aligned(16))) unsigned char lds[];
    Frame F;
    F.lds = (LAS unsigned char*)lds;
    F.MISC = (volatile LAS unsigned*)(F.lds + MISC_OFF);
    F.tid = threadIdx.x; F.lane = F.tid & 63; F.wave = __builtin_amdgcn_readfirstlane(F.tid >> 6);
    F.G = gridDim.x; { const int bx = blockIdx.x; F.vcu = (F.G % 8 == 0) ? (bx % 8) * (F.G / 8) + bx / 8 : bx; }
    unsigned char* ws = args.ws;
    F.ctl = (gu32*)(ws + WS_CTL);
    Ptrs P;
#pragma unroll
    for (int i = 0; i < 25; ++i) P.in[i] = args.in[i];
    P.out = args.out; P.ws = ws;
    for (int u = F.tid; u < (LDS_BYTES - LDSCTL_OFF) / 4; u += NWAVES * 64) ((LAS unsigned*)(F.lds + LDSCTL_OFF))[u] = 0u;
    __syncthreads();
    XcdBarrier bar; bar.bar = (unsigned*)(F.ctl + CW_BAR); bar.x = 0; bar.st = nullptr;
    if (!MK_PER_PHASE) bar = xcd_barrier_post((unsigned*)(F.ctl + CW_BAR), F.MISC + 8);
#define GRID_BAR() do { if (!MK_PER_PHASE) xcd_barrier(bar); } while (0)
    const int lo = args.ph_lo, hi = args.ph_hi;
#define IN(k) (lo <= (k) && (k) < hi)
#define BOTH(k) (IN(k) && IN((k) + 1))

    bf16* W1T = (bf16*)(ws + WS_W1T); bf16* WO1T = (bf16*)(ws + WS_WO1T); bf16* W3T = (bf16*)(ws + WS_W3T); bf16* WO2T = (bf16*)(ws + WS_WO2T); bf16* W2T = (bf16*)(ws + WS_W2T);
    bf16* XN = (bf16*)(ws + WS_XN); bf16* Y1 = (bf16*)(ws + WS_Y1); bf16* QL = (bf16*)(ws + WS_QL); bf16* YC = (bf16*)(ws + WS_YC);
    unsigned long long* MASK = (unsigned long long*)(ws + WS_MASK);
    float* stats = (float*)(ws + WS_STATS); const float* mods = (const float*)(ws + WS_MODS);

    if (IN(0)) { p0_prologue(F, P); if (BOTH(0)) GRID_BAR(); }
    if (IN(1)) { xn_phase(F, P.in[0], P.in[4], mods, XN); if (BOTH(1)) GRID_BAR(); }
    if (IN(2)) {
        pg8::Gemm g{XN, W1T, M, N1, 1024, 1024, 1024}; pg8::StaticOrder S; S.init(M, N1, F.G, (int)blockIdx.x);
        pg8::EpiStoreBf16 E{Y1, N1, stats, 6};
        pg8::gemm_phase<pg8::EpiStoreBf16, pg8::StaticOrder, true, true>(F.lds + RING_OFF, g, S, E);
        if (BOTH(2)) GRID_BAR();
    }
    if (IN(3)) {
        pg8::Gemm g{Y1 + Y1_CQ, W2T, M, N2, 256, N1, 256}; pg8::StaticOrder S; S.init(M, N2, F.G, (int)blockIdx.x);
        pg8::EpiScaleBf16 E{QL, N2, stats, 5, EPS};
        pg8::gemm_phase<pg8::EpiScaleBf16, pg8::StaticOrder, true, true>(F.lds + RING_OFF, g, S, E);
        if (BOTH(3)) GRID_BAR();
    }
    if (IN(4)) { indexer_naive(F, Y1, QL, MASK); if (BOTH(4)) GRID_BAR(); }
    if (IN(5)) { diffattn_naive(F, P, Y1, YC); dsa_naive(F, Y1, QL, MASK, YC); if (BOTH(5)) GRID_BAR(); }
    if (IN(6)) {
        pg8::Gemm g{YC, WO1T, M, 1024, 1024, 1024, 1024}; pg8::StaticOrder S; S.init(M, 1024, F.G, (int)blockIdx.x);
        pg8::EpiResid E{P.in[0], P.out, mods + 2048, 3072};
        pg8::gemm_phase<pg8::EpiResid, pg8::StaticOrder, false, true>(F.lds + RING_OFF, g, S, E);
        if (BOTH(6)) GRID_BAR();
    }
    if (IN(7)) { xn_phase(F, P.out, P.in[4] + 1024, mods + 8 * 3072, XN); if (BOTH(7)) GRID_BAR(); }
    if (IN(8)) {
        pg8::Gemm g{XN, W3T, M, N3, 1024, 1024, 1024}; pg8::StaticOrder S; S.init(M, N3, F.G, (int)blockIdx.x);
        pg8::EpiStoreBf16 E{Y1, N3, nullptr, -1};
        pg8::gemm_phase<pg8::EpiStoreBf16, pg8::StaticOrder, true, true>(F.lds + RING_OFF, g, S, E);
        if (BOTH(8)) GRID_BAR();
    }
    if (IN(9)) { swa_naive(F, P, Y1, YC); __syncthreads(); conv_phase(F, P, Y1, YC); if (BOTH(9)) GRID_BAR(); }
    if (IN(10)) {
        pg8::Gemm g{YC, WO2T, M, 1024, 1024, 1024, 1024}; pg8::StaticOrder S; S.init(M, 1024, F.G, (int)blockIdx.x);
        pg8::EpiResid E{P.out, P.out, mods + 8 * 3072 + 2048, 3072};
        pg8::gemm_phase<pg8::EpiResid, pg8::StaticOrder, false, true>(F.lds + RING_OFF, g, S, E);
        if (BOTH(10)) GRID_BAR();
    }
    if (IN(11)) { final_norm_phase(F, P.out, P.in[24]); }
#undef IN
#undef BOTH
}

extern "C" void kernel_launch(void* const* d_in, const int* in_sizes, int n_in, void* d_out, int out_size, void* d_ws, size_t ws_size, hipStream_t stream) {
    static int grid = 0;
    if (grid == 0) {
        if (n_in != 25 || in_sizes[0] != M * DM || out_size != M * DM || ws_size < WS_END) { fprintf(stderr, "kernel_launch: unexpected shapes (n_in %d, in0 %d, out %d, ws %zu); nothing launched\n", n_in, n_in > 0 ? in_sizes[0] : -1, out_size, ws_size); grid = -1; return; }
        int dev = 0, cus = 0, per_cu = 0;
        if (hipGetDevice(&dev) != hipSuccess || hipDeviceGetAttribute(&cus, hipDeviceAttributeMultiprocessorCount, dev) != hipSuccess) { grid = -1; return; }
        if (hipFuncSetAttribute((const void*)mega_fwd, hipFuncAttributeMaxDynamicSharedMemorySize, LDS_BYTES) != hipSuccess) { fprintf(stderr, "kernel_launch: hipFuncSetAttribute failed\n"); grid = -1; return; }
        if (hipOccupancyMaxActiveBlocksPerMultiprocessor(&per_cu, (const void*)mega_fwd, NWAVES * 64, LDS_BYTES) != hipSuccess || per_cu < 1)
            fprintf(stderr, "kernel_launch: note: occupancy query reports %d workgroups per CU\n", per_cu);
        (void)hipGetLastError();
        grid = cus;
    }
    if (grid < 0) return;
    if (hipMemsetAsync((char*)d_ws + WS_CTL, 0, CTL_ZERO_BYTES, stream) != hipSuccess) { fprintf(stderr, "kernel_launch: hipMemsetAsync failed\n"); return; }
    Args a{};
    for (int i = 0; i < 25; ++i) a.in[i] = (const float*)d_in[i];
    a.out = (float*)d_out; a.ws = (unsigned char*)d_ws;
#if MK_PER_PHASE
    for (int ph = 0; ph < N_PHASES; ++ph) { a.ph_lo = ph; a.ph_hi = ph + 1; hipLaunchKernelGGL(mega_fwd, dim3(grid), dim3(NWAVES * 64), LDS_BYTES, stream, a); }
#else
    a.ph_lo = 0; a.ph_hi = N_PHASES;
    hipLaunchKernelGGL(mega_fwd, dim3(grid), dim3(NWAVES * 64), LDS_BYTES, stream, a);
#endif
    const hipError_t le = hipPeekAtLastError();
    if (le != hipSuccess) fprintf(stderr, "kernel_launch: launch failed: %s\n", hipGetErrorName(le));
}
```

```cpp
#include <hip/hip_runtime.h>
#include <cstdio>
#include <cstdint>
namespace pg8 {
#define PG8_LAS __attribute__((address_space(3)))
typedef unsigned short bf16_t;
typedef short bf16x8 __attribute__((ext_vector_type(8)));
typedef float f32x4 __attribute__((ext_vector_type(4)));
typedef unsigned u32x4 __attribute__((ext_vector_type(4)));
constexpr int BM = 256, BK = 64, HALF = 128, HTB = HALF * BK * 2  , STAGE_BYTES = 8 * HTB, NXCD = 8, WGM = 8;

__host__ __device__ __forceinline__ int lds_byte(int r, int c) { const int st = (r >> 4) * 2 + (c >> 5), rr = r & 15, cc = c & 31, ob = rr * 64 + cc * 2; return st * 1024 + (ob ^ (((ob >> 9) & 1) << 5)); }
__host__ __device__ __forceinline__ void stage_rc(int b, int& R, int& C) { const int st = b / 1024, sb = b % 1024, swz = sb ^ (((sb >> 9) & 1) << 5); R = (st >> 1) * 16 + swz / 64; C = (st & 1) * 32 + (swz % 64) / 2; }
__host__ __device__ __forceinline__ int perm32(int rho) { const int n = rho >> 4, i = rho & 15; return 8 * (i >> 2) + 4 * n + (i & 3); }

struct Unit { int pm, pn; };
struct Gemm { const bf16_t* A; const bf16_t* Bt; int M, N, K, lda, ldb; };

struct StaticOrder {
    int nM, nN, nwg, G, c;
    __host__ __device__ void init(int M, int N, int G_, int c_) { nM = M / BM; nN = N / BM; nwg = nM * nN; G = G_; c = c_; }
    __host__ __device__ bool next(int i, Unit& u) const {
        const long L = (long)i * G + c; if (L >= nwg) return false;
        int wgid = (int)L; { const int q = nwg / NXCD, r = nwg % NXCD, xcd = wgid % NXCD, off = wgid / NXCD; wgid = (xcd < r ? xcd * (q + 1) : r * (q + 1) + (xcd - r) * q) + off; }
        const int nig = WGM * nN, gid = wgid / nig, fm = gid * WGM, gsz = (nM - fm) < WGM ? (nM - fm) : WGM;
        u.pm = fm + ((wgid % nig) % gsz); u.pn = (wgid % nig) / gsz; return true;
    }
    __device__ __forceinline__ void a_ready(const Unit&) const {}
    __device__ __forceinline__ void done(const Unit&) const {}
};

__device__ __forceinline__ unsigned cvt_pk_bf16(float lo, float hi) { unsigned r; asm volatile("v_cvt_pk_bf16_f32 %0, %1, %2" : "=v"(r) : "v"(lo), "v"(hi)); return r; }

struct EpiStoreBf16 {
    static constexpr bool PERM = true, AFTER_DRAIN = false;
    bf16_t* O; int ldc; float* stats; int stat_pn;
    __device__ __forceinline__ void operator()(const f32x4 (&acc)[2][2][4][2], const Unit& u, int wr, int wc, int fr, int fq) const {
        const int row0 = u.pm * BM + wr * 64 + fr, col0 = u.pn * BM + wc * 32 + 8 * fq;
#pragma unroll
        for (int ai = 0; ai < 2; ++ai)
#pragma unroll
            for (int m = 0; m < 4; ++m) { bf16_t* rowp = O + (size_t)(row0 + ai * HALF + m * 16) * ldc + col0;
#pragma unroll
                for (int bj = 0; bj < 2; ++bj) { const f32x4 v0 = acc[ai][bj][m][0], v1 = acc[ai][bj][m][1];
                    u32x4 w; w.x = cvt_pk_bf16(v0[0], v0[1]); w.y = cvt_pk_bf16(v0[2], v0[3]); w.z = cvt_pk_bf16(v1[0], v1[1]); w.w = cvt_pk_bf16(v1[2], v1[3]);
                    *(u32x4*)(rowp + bj * HALF) = w; } }
        if (stats != nullptr && u.pn == stat_pn) {
#pragma unroll
            for (int ai = 0; ai < 2; ++ai)
#pragma unroll
                for (int m = 0; m < 4; ++m)
#pragma unroll
                    for (int bj = 0; bj < 2; ++bj) { const f32x4 v0 = acc[ai][bj][m][0], v1 = acc[ai][bj][m][1];
                        float s = (v0[0] * v0[0] + v0[1] * v0[1]) + (v0[2] * v0[2] + v0[3] * v0[3]) + (v1[0] * v1[0] + v1[1] * v1[1]) + (v1[2] * v1[2] + v1[3] * v1[3]);
                        s += __shfl_xor(s, 16); s += __shfl_xor(s, 32);
                        if (fq == 0) atomicAdd(stats + (size_t)(row0 + ai * HALF + m * 16) * 2 + bj, s); }
        }
    }
};
struct EpiScaleBf16 {
    static constexpr bool PERM = true, AFTER_DRAIN = false;
    bf16_t* O; int ldc; const float* stats; int pn_split; float eps;
    __device__ __forceinline__ void operator()(const f32x4 (&acc)[2][2][4][2], const Unit& u, int wr, int wc, int fr, int fq) const {
        const int row0 = u.pm * BM + wr * 64 + fr, col0 = u.pn * BM + wc * 32 + 8 * fq, si = (u.pn < pn_split) ? 0 : 1;
#pragma unroll
        for (int ai = 0; ai < 2; ++ai)
#pragma unroll
            for (int m = 0; m < 4; ++m) { const int row = row0 + ai * HALF + m * 16; bf16_t* rowp = O + (size_t)row * ldc + col0;
                const float rs = 1.0f / sqrtf(stats[(size_t)row * 2 + si] * (1.0f / 128.0f) + eps);
#pragma unroll
                for (int bj = 0; bj < 2; ++bj) { const f32x4 v0 = acc[ai][bj][m][0] * rs, v1 = acc[ai][bj][m][1] * rs;
                    u32x4 w; w.x = cvt_pk_bf16(v0[0], v0[1]); w.y = cvt_pk_bf16(v0[2], v0[3]); w.z = cvt_pk_bf16(v1[0], v1[1]); w.w = cvt_pk_bf16(v1[2], v1[3]);
                    *(u32x4*)(rowp + bj * HALF) = w; } }
    }
};
struct EpiResid {
    static constexpr bool PERM = false, AFTER_DRAIN = false;
    const float* resid; float* out; const float* gate; int gstride;
    __device__ __forceinline__ void operator()(const f32x4 (&acc)[2][2][4][2], const Unit& u, int wr, int wc, int fr, int fq) const {
        const int row0 = u.pm * BM + wr * 64 + fr, col0 = u.pn * BM + wc * 32 + 4 * fq;
        const float* gp = gate + (size_t)(u.pm >> 3) * gstride + col0;
        f32x4 gv[2][2];
#pragma unroll
        for (int bj = 0; bj < 2; ++bj)
#pragma unroll
            for (int n = 0; n < 2; ++n) gv[bj][n] = *(const f32x4*)(gp + bj * HALF + n * 16);
#pragma unroll
        for (int ai = 0; ai < 2; ++ai)
#pragma unroll
            for (int m = 0; m < 4; ++m) { const size_t off = (size_t)(row0 + ai * HALF + m * 16) * 1024 + col0;
#pragma unroll
                for (int bj = 0; bj < 2; ++bj)
#pragma unroll
                    for (int n = 0; n < 2; ++n) { const f32x4 r = *(const f32x4*)(resid + off + bj * HALF + n * 16); *(f32x4*)(out + off + bj * HALF + n * 16) = r + gv[bj][n] * acc[ai][bj][m][n]; }
                if (m & 1) asm volatile("" ::: "memory"); }
    }
};

template <class Epi, class Sched, bool ALIGN_EPI = false, bool SP2 = false>
__device__ __forceinline__ void gemm_phase(PG8_LAS unsigned char* lds, const Gemm g, const Sched& S, const Epi& E) {
    const int tid = threadIdx.x, wid = __builtin_amdgcn_readfirstlane(tid >> 6), lane = tid & 63, wr = wid >> 2, wc = wid & 3, fr = lane & 15, fq = lane >> 4;
    const int K = g.K, nt = K / BK;
    unsigned voffA[2], voffB[2];
#pragma unroll
    for (int i = 0; i < 2; ++i) { int R, C; stage_rc(tid * 16 + i * 8192, R, C); const int Rb = Epi::PERM ? ((R & ~31) + perm32(R & 31)) : R;
        voffA[i] = (unsigned)(R * g.lda + C) * 2u; voffB[i] = (unsigned)(Rb * g.ldb + C) * 2u; }
    const size_t kstep = (size_t)(BK * 2);
    const size_t hstepA = (size_t)HALF * g.lda * 2, hstepB = (size_t)HALF * g.ldb * 2;
    const size_t tstepA = 2 * hstepA, tstepB = 2 * hstepB;
    const unsigned ldsw = (unsigned)wid * 1024u;
    const int aoff = lds_byte(wr * 64 + fr, fq * 8), boff = lds_byte(wc * 32 + fr, fq * 8);
#define PG8_SA(b, h) (((b) * 2 + (h)) * HTB)
#define PG8_SB(b, h) ((4 + (b) * 2 + (h)) * HTB)
#define PG8_STAGE(bufoff, gbase, voff) do { _Pragma("unroll") for (int _i = 0; _i < 2; ++_i) \
        __builtin_amdgcn_global_load_lds((const unsigned*)((const char*)(gbase) + (voff)[_i]), (PG8_LAS unsigned*)(lds + (bufoff) + ldsw + _i * 8192), 16, 0, 0); } while (0)
#define PG8_LDA(dst, b, h) do { _Pragma("unroll") for (int m = 0; m < 4; ++m) _Pragma("unroll") for (int k = 0; k < 2; ++k) dst[m][k] = *(const PG8_LAS bf16x8*)(lds + PG8_SA(b, h) + aoff + m * 2048 + k * 1024); } while (0)
#define PG8_LDB(dst, b, h) do { _Pragma("unroll") for (int n = 0; n < 2; ++n) _Pragma("unroll") for (int k = 0; k < 2; ++k) dst[n][k] = *(const PG8_LAS bf16x8*)(lds + PG8_SB(b, h) + boff + n * 2048 + k * 1024); } while (0)
#define PG8_MMA(ai, bj, At, Bt) do { __builtin_amdgcn_s_setprio(1); _Pragma("unroll") for (int m = 0; m < 4; ++m) _Pragma("unroll") for (int n = 0; n < 2; ++n) _Pragma("unroll") for (int k = 0; k < 2; ++k) \
        acc[ai][bj][m][n] = __builtin_amdgcn_mfma_f32_16x16x32_bf16(Bt[n][k], At[m][k], acc[ai][bj][m][n], 0, 0, 0); __builtin_amdgcn_s_setprio(0); } while (0)
#define PG8_WAIT_V(n) asm volatile("s_waitcnt vmcnt(" #n ")" ::: "memory")
#define PG8_WAIT_L(n) asm volatile("s_waitcnt lgkmcnt(" #n ")" ::: "memory")
#define PG8_BAR __builtin_amdgcn_s_barrier()
#define PG8_SCHED __builtin_amdgcn_sched_barrier(0)
    Unit cur, nxt; int ui = 0;
    if (!S.next(0, cur)) return;
    f32x4 acc[2][2][4][2];
#pragma unroll
    for (int a = 0; a < 2; ++a)
#pragma unroll
        for (int b = 0; b < 2; ++b)
#pragma unroll
            for (int m = 0; m < 4; ++m)
#pragma unroll
                for (int n = 0; n < 2; ++n) acc[a][b][m][n] = (f32x4){0.f, 0.f, 0.f, 0.f};
    bf16x8 At[4][2], B0[2][2], B1[2][2];
    const char* cA = (const char*)g.A + (size_t)cur.pm * tstepA; const char* cB = (const char*)g.Bt + (size_t)cur.pn * tstepB;
    S.a_ready(cur);
    if constexpr (SP2) {
        PG8_STAGE(PG8_SB(0, 0), cB, voffB); PG8_STAGE(PG8_SB(0, 1), cB + hstepB, voffB); PG8_STAGE(PG8_SA(0, 0), cA, voffA); PG8_STAGE(PG8_SA(0, 1), cA + hstepA, voffA);
        if (wr == 1) PG8_BAR;
        PG8_WAIT_V(2); PG8_BAR;
        PG8_STAGE(PG8_SB(1, 0), cB + kstep, voffB); PG8_STAGE(PG8_SA(1, 0), cA + kstep, voffA); PG8_STAGE(PG8_SB(1, 1), cB + hstepB + kstep, voffB);
        PG8_WAIT_V(6); PG8_BAR;
    } else {
        PG8_STAGE(PG8_SB(0, 0), cB, voffB); PG8_STAGE(PG8_SA(0, 0), cA, voffA); PG8_STAGE(PG8_SB(0, 1), cB + hstepB, voffB); PG8_STAGE(PG8_SA(0, 1), cA + hstepA, voffA);
        if (wr == 1) PG8_BAR;
        PG8_WAIT_V(4); PG8_BAR;
        PG8_STAGE(PG8_SB(1, 0), cB + kstep, voffB); PG8_STAGE(PG8_SA(1, 0), cA + kstep, voffA); PG8_STAGE(PG8_SB(1, 1), cB + hstepB + kstep, voffB);
        PG8_WAIT_V(6); PG8_BAR;
    }
    for (;;) {
        const bool has_next = S.next(ui + 1, nxt);
        const char* nA = has_next ? (const char*)g.A + (size_t)nxt.pm * tstepA : cA; const char* nB = has_next ? (const char*)g.Bt + (size_t)nxt.pn * tstepB : cB;
        for (int t = 0; t < nt; t += 2) {
            const bool last = (t == nt - 2);
            const char* a1 = cA + (size_t)(t + 1) * kstep;
            const char* a2 = last ? nA : cA + (size_t)(t + 2) * kstep; const char* b2 = last ? nB : cB + (size_t)(t + 2) * kstep;
            const char* a3 = a2 + kstep; const char* b3 = b2 + kstep;
            if (last && has_next) S.a_ready(nxt);
            if constexpr (SP2) {
            PG8_LDB(B0, 0, 0); PG8_LDB(B1, 0, 1); PG8_SCHED; PG8_LDA(At, 0, 0); PG8_STAGE(PG8_SA(1, 1), a1 + hstepA, voffA);
            PG8_WAIT_V(8); PG8_WAIT_L(0); PG8_BAR; PG8_MMA(0, 0, At, B0); PG8_MMA(0, 1, At, B1); PG8_BAR; PG8_SCHED;
            PG8_LDA(At, 0, 1); PG8_STAGE(PG8_SB(0, 0), b2, voffB); PG8_STAGE(PG8_SB(0, 1), b2 + hstepB, voffB); PG8_STAGE(PG8_SA(0, 0), a2, voffA);
            PG8_WAIT_V(8); PG8_WAIT_L(0); PG8_BAR; PG8_MMA(1, 0, At, B0); PG8_MMA(1, 1, At, B1); PG8_BAR; PG8_SCHED;
            PG8_LDB(B0, 1, 0); PG8_LDB(B1, 1, 1); PG8_SCHED; PG8_LDA(At, 1, 0); PG8_STAGE(PG8_SA(0, 1), a2 + hstepA, voffA);
            PG8_WAIT_V(8); PG8_WAIT_L(0); PG8_BAR; PG8_MMA(0, 0, At, B0); PG8_MMA(0, 1, At, B1); PG8_BAR; PG8_SCHED;
            PG8_LDA(At, 1, 1); PG8_STAGE(PG8_SB(1, 0), b3, voffB); PG8_STAGE(PG8_SB(1, 1), b3 + hstepB, voffB); PG8_STAGE(PG8_SA(1, 0), a3, voffA);
            PG8_WAIT_V(8); PG8_WAIT_L(0); PG8_BAR; PG8_MMA(1, 0, At, B0); PG8_MMA(1, 1, At, B1); PG8_BAR; PG8_SCHED;
            } else {
            PG8_LDB(B0, 0, 0); PG8_SCHED; PG8_LDA(At, 0, 0); PG8_STAGE(PG8_SA(1, 1), a1 + hstepA, voffA);
            PG8_WAIT_L(8); PG8_BAR; PG8_WAIT_L(0); PG8_MMA(0, 0, At, B0); PG8_BAR; PG8_SCHED;
            PG8_LDB(B1, 0, 1); PG8_STAGE(PG8_SB(0, 0), b2, voffB);
            PG8_BAR; PG8_WAIT_L(0); PG8_MMA(0, 1, At, B1); PG8_BAR;
            PG8_LDA(At, 0, 1); PG8_STAGE(PG8_SA(0, 0), a2, voffA);
            PG8_BAR; PG8_WAIT_L(0); PG8_MMA(1, 0, At, B0); PG8_BAR; PG8_SCHED;
            PG8_STAGE(PG8_SB(0, 1), b2 + hstepB, voffB);
            PG8_WAIT_V(6); PG8_BAR; PG8_MMA(1, 1, At, B1); PG8_BAR;
            PG8_LDB(B0, 1, 0); PG8_SCHED; PG8_LDA(At, 1, 0); PG8_STAGE(PG8_SA(0, 1), a2 + hstepA, voffA);
            PG8_WAIT_L(8); PG8_BAR; PG8_WAIT_L(0); PG8_MMA(0, 0, At, B0); PG8_BAR; PG8_SCHED;
            PG8_LDB(B1, 1, 1); PG8_STAGE(PG8_SB(1, 0), b3, voffB);
            PG8_BAR; PG8_WAIT_L(0); PG8_MMA(0, 1, At, B1); PG8_BAR;
            PG8_LDA(At, 1, 1); PG8_STAGE(PG8_SA(1, 0), a3, voffA);
            PG8_BAR; PG8_WAIT_L(0); PG8_MMA(1, 0, At, B0); PG8_BAR; PG8_SCHED;
            PG8_STAGE(PG8_SB(1, 1), b3 + hstepB, voffB);
            PG8_WAIT_V(6); PG8_BAR; PG8_MMA(1, 1, At, B1); PG8_BAR;
            }
        }
        if constexpr (ALIGN_EPI) { if (wr == 0) PG8_BAR; }
        if constexpr (!Epi::AFTER_DRAIN) { E(acc, cur, wr, wc, fr, fq); S.done(cur); }
        if (!has_next) break;
#pragma unroll
        for (int a = 0; a < 2; ++a)
#pragma unroll
            for (int b = 0; b < 2; ++b)
#pragma unroll
                for (int m = 0; m < 4; ++m)
#pragma unroll
                    for (int n = 0; n < 2; ++n) acc[a][b][m][n] = (f32x4){0.f, 0.f, 0.f, 0.f};
        cur = nxt; cA = nA; cB = nB; ++ui;
        if constexpr (ALIGN_EPI) { if (wr == 1) PG8_BAR; }
    }
    PG8_WAIT_V(0);
    if constexpr (!ALIGN_EPI) { if (wr == 0) PG8_BAR; }
    PG8_BAR;
    if constexpr (Epi::AFTER_DRAIN) { E.fused(acc, cur, wr, wc, fr, fq, lds, wid, lane); S.done(cur); }
#undef PG8_SA
#undef PG8_SB
#undef PG8_STAGE
#undef PG8_LDA
#undef PG8_LDB
#undef PG8_MMA
#undef PG8_WAIT_V
#undef PG8_WAIT_L
#undef PG8_BAR
#undef PG8_SCHED
}
}

constexpr int NWAVES = 8;
constexpr int BATCH = 8, SEQ = 2048, DM = 1024, M = BATCH * SEQ;
constexpr int N1 = 3072;
constexpr int N1SRC = 2856;
constexpr int Y1_QA = 0, Y1_KA = 512, Y1_VA = 1024, Y1_CQ = 1536, Y1_KIDX = 1792, Y1_WIDX = 1824, Y1_GATE = 2048;
constexpr int N2 = 2048;
constexpr int QL_QIDX = 1024, QL_KV = 1280, QL_VP = 1408;
constexpr int N3 = 2816;
constexpr int Y2_KC = 512, Y2_VC = 640, Y2_DVAL = 768, Y2_DGATE = 1280, Y2_GATE = 1792;
constexpr float EPS = 1e-6f, LOG2E = 1.4426950408889634f;
constexpr float CQK = 0.125f * LOG2E;
constexpr float CQL = 0.08838834764831845f * LOG2E;
constexpr float LAM_INIT = 0.2f;
constexpr int TOPK = 256;

constexpr size_t MiB = 1u << 20;
constexpr size_t WS_CTL = 0, CTL_ZERO_BYTES = 1 * MiB;
constexpr size_t WS_STATS = 512 * 1024;
constexpr size_t WS_MODS = 1 * MiB;
constexpr size_t WS_W1T = 2 * MiB;
constexpr size_t WS_WO1T = 8 * MiB;
constexpr size_t WS_W3T = 10 * MiB;
constexpr size_t WS_WO2T = 16 * MiB;
constexpr size_t WS_W2T = 18 * MiB;
constexpr size_t WS_XN = 20 * MiB;
constexpr size_t WS_Y1 = 52 * MiB;
constexpr size_t WS_QL = 148 * MiB;
constexpr size_t WS_YC = 212 * MiB;
constexpr size_t WS_MASK = 244 * MiB;
constexpr size_t WS_END = 248 * MiB;
constexpr int CW_BAR = 4096;

constexpr int RING_OFF = 0, RING_BYTES = 131072;
constexpr int LDSCTL_OFF = RING_BYTES, MISC_OFF = LDSCTL_OFF + 320;
constexpr int LDS_BYTES = 147456;

#define GAS __attribute__((address_space(1)))
#define LAS __attribute__((address_space(3)))
typedef unsigned short bf16;
typedef unsigned v4u __attribute__((ext_vector_type(4)));
typedef float f32x4 __attribute__((ext_vector_type(4)));
typedef short bf16x8 __attribute__((ext_vector_type(8)));
typedef GAS unsigned gu32;
typedef GAS unsigned long long gu64;
#define RLX_AGENT __ATOMIC_RELAXED, __HIP_MEMORY_SCOPE_AGENT
#define LDS_WAIT() asm volatile("s_waitcnt lgkmcnt(0)" ::: "memory")
#define VM_WAIT() asm volatile("s_waitcnt vmcnt(0)" ::: "memory")
__device__ __forceinline__ unsigned long long rt() { return __builtin_amdgcn_s_memrealtime(); }
__device__ __forceinline__ unsigned f2bf(float f) { unsigned u = __builtin_bit_cast(unsigned, f); return (u + 0x7fffu + ((u >> 16) & 1u)) >> 16; }
__device__ __forceinline__ unsigned pk2(float lo, float hi) { return f2bf(lo) | (f2bf(hi) << 16); }

#define XB_TMO      128
#define XB_XCNT(j)  (256  + 64 * (j))
#define XB_XSUB(j)  (1280 + 64 * (j))
#define XB_XGEN(j)  (2304 + 64 * (j))
#define XB_TOP      3328
#define XB_TOPGEN   3392
#define XCD_BAR_WORDS 3456
#define XB_SPIN_CAP (1u << 18)

__device__ __forceinline__ unsigned xb_ld(unsigned* p)              { return __hip_atomic_load(p, __ATOMIC_RELAXED, __HIP_MEMORY_SCOPE_AGENT); }
__device__ __forceinline__ unsigned xb_add(unsigned* p, unsigned v) { return __hip_atomic_fetch_add(p, v, __ATOMIC_RELAXED, __HIP_MEMORY_SCOPE_AGENT); }
__device__ __forceinline__ unsigned xb_xcc_id() { return (unsigned)__builtin_amdgcn_s_getreg((3 << 11) | 20) & 0xFu; }
#define XB_SPIN(cond, bar) do { unsigned _sp = 0; while (cond) { __builtin_amdgcn_s_sleep(1); \
    if ((++_sp & 255u) == 0u) { if (xb_ld(&(bar)[XB_TMO])) break; if (_sp > XB_SPIN_CAP) { atomicAdd(&(bar)[XB_TMO], 1u); break; } } } } while (0)

struct XcdBarrier {
    unsigned* bar; unsigned x;
    volatile LAS unsigned* st;
};

__device__ __forceinline__ XcdBarrier xcd_barrier_post(unsigned* bar, volatile LAS unsigned* st) {
    XcdBarrier b; b.bar = bar; b.x = xb_xcc_id(); b.st = st;
    if (threadIdx.x == 0) (void)xb_add(&bar[XB_XCNT(b.x)], 1u);
    return b;
}
__device__ __forceinline__ void xcd_barrier_complete(unsigned* bar, unsigned x, unsigned& nloc, unsigned& nx) {
    const unsigned G = gridDim.x * gridDim.y * gridDim.z;
    unsigned sum, cnt, mine, sp = 0u;
    for (;;) {
        sum = 0u; cnt = 0u; mine = 0u;
#pragma unroll
        for (unsigned j = 0; j < 16; ++j) { const unsigned c = xb_ld(&bar[XB_XCNT(j)]); sum += c; cnt += (c > 0u) ? 1u : 0u; mine = (j == x) ? c : mine; }
        if (sum == G) break;
        __builtin_amdgcn_s_sleep(1);
        if ((++sp & 255u) == 0u) { if (xb_ld(&bar[XB_TMO])) break; if (sp > XB_SPIN_CAP) { atomicAdd(&bar[XB_TMO], 1u); break; } }
    }
    nloc = mine > 0u ? mine : 1u; nx = cnt > 0u ? cnt : 1u;
}

__device__ __forceinline__ void xcd_barrier(const XcdBarrier& b) {
    asm volatile("s_waitcnt vmcnt(0)" ::: "memory");
    __syncthreads();
    if (threadIdx.x == 0) {
        unsigned* bar = b.bar;
        __builtin_amdgcn_s_waitcnt(0);
        unsigned nloc = b.st[0], nx = b.st[1];
        if (nloc == 0u) { xcd_barrier_complete(bar, b.x, nloc, nx); b.st[0] = nloc; b.st[1] = nx; }
        const unsigned old = xb_add(&bar[XB_XSUB(b.x)], 1u);
        const unsigned gen = old / nloc;
        if (old + 1u == (gen + 1u) * nloc) {
            __builtin_amdgcn_fence(__ATOMIC_RELEASE, "agent");
            asm volatile("s_waitcnt vmcnt(0)" ::: "memory");
            const unsigned og = xb_add(&bar[XB_TOP], 1u);
            const unsigned tg = og / nx;
            if (og + 1u == (tg + 1u) * nx) xb_add(&bar[XB_TOPGEN], 1u);
            else XB_SPIN(xb_ld(&bar[XB_TOPGEN]) == tg, bar);
            __builtin_amdgcn_fence(__ATOMIC_ACQUIRE, "agent");
            xb_add(&bar[XB_XGEN(b.x)], 1u);
            asm volatile("s_waitcnt vmcnt(0)" ::: "memory");
        } else {
            XB_SPIN(xb_ld(&bar[XB_XGEN(b.x)]) == gen, bar);
            __builtin_amdgcn_fence(__ATOMIC_ACQUIRE, "agent");
            asm volatile("s_waitcnt vmcnt(0)" ::: "memory");
        }
    }
    __syncthreads();
}


struct Frame {
    LAS unsigned char* lds;
    volatile LAS unsigned* MISC;
    gu32* ctl;
    int tid, lane, wave;
    int vcu, G;
};
__device__ __forceinline__ float wave_sum(float v) {
#pragma unroll
    for (int o = 1; o < 64; o <<= 1) v += __shfl_xor(v, o);
    return v;
}
__device__ __forceinline__ float wave_max(float v) {
#pragma unroll
    for (int o = 1; o < 64; o <<= 1) v = fmaxf(v, __shfl_xor(v, o));
    return v;
}
__device__ __forceinline__ float bflo(unsigned w) { return __uint_as_float(w << 16); }
__device__ __forceinline__ float bfhi(unsigned w) { return __uint_as_float(w & 0xffff0000u); }
__device__ __forceinline__ float bf2f(bf16 u) { return __uint_as_float((unsigned)u << 16); }
__device__ __forceinline__ float silu_f(float g) { return g / (1.0f + __expf(-g)); }

template <int KIND> __device__ __forceinline__ int map_col(int d, float& sc) {
    sc = 1.0f;
    if (KIND == 0) { if (d < 512) sc = CQK; if (d < 1832) return d; if (d < 2048) return -1; return d - 216; }
    if (KIND == 2) { if (d < 512) sc = CQK; return d; }
    return d;
}
template <int KIND> __device__ __forceinline__ void p0_transpose_item(const float* W, int K, int Nsrc, int Ndst, bf16* WT, LAS float* scr, int item, int lane) {
    const int nblk = Ndst / 32, kb = item / nblk, nb = item % nblk, k0 = 64 * kb, n0 = 32 * nb;
    float sc; const int src = map_col<KIND>(n0 + (lane & 31), sc);
#pragma unroll 8
    for (int i = 0; i < 32; ++i) { const int kk = 2 * i + (lane >> 5); scr[kk * 33 + (lane & 31)] = (src >= 0) ? W[(size_t)(k0 + kk) * Nsrc + src] * sc : 0.0f; }
    LDS_WAIT(); asm volatile("" ::: "memory");
    const int c = lane & 7;
#pragma unroll
    for (int j = 0; j < 4; ++j) { const int n = (lane >> 3) + 8 * j; const LAS float* s = scr + (8 * c) * 33 + n;
        v4u o; o.x = pk2(s[0 * 33], s[1 * 33]); o.y = pk2(s[2 * 33], s[3 * 33]); o.z = pk2(s[4 * 33], s[5 * 33]); o.w = pk2(s[6 * 33], s[7 * 33]);
        *(GAS v4u*)(WT + (size_t)(n0 + n) * K + k0 + 8 * c) = o; }
    LDS_WAIT(); asm volatile("" ::: "memory");
}
struct Ptrs {
    const float* in[25]; float* out; unsigned char* ws;
};
__device__ __forceinline__ void p0_prologue(Frame& F, const Ptrs& P) {
    LAS float* scr = (LAS float*)(F.lds + RING_OFF + F.wave * 16384);
    const int gw = F.vcu * NWAVES + F.wave, NGW = F.G * NWAVES;
    bf16* W1T = (bf16*)(P.ws + WS_W1T); bf16* WO1T = (bf16*)(P.ws + WS_WO1T); bf16* W3T = (bf16*)(P.ws + WS_W3T); bf16* WO2T = (bf16*)(P.ws + WS_WO2T); bf16* W2T = (bf16*)(P.ws + WS_W2T);
    constexpr int I_1 = 16 * (N1 / 32), I_O = 16 * 32, I_3 = 16 * (N3 / 32);
    constexpr int NITEMS = I_1 + I_O + I_3 + I_O;
    for (int it = gw; it < NITEMS; it += NGW) {
        int r = it;
        if (r < I_1) { p0_transpose_item<0>(P.in[5], 1024, N1SRC, N1, W1T, scr, r, F.lane); continue; } r -= I_1;
        if (r < I_O) { p0_transpose_item<1>(P.in[16], 1024, 1024, 1024, WO1T, scr, r, F.lane); continue; } r -= I_O;
        if (r < I_3) { p0_transpose_item<2>(P.in[17], 1024, N3, N3, W3T, scr, r, F.lane); continue; } r -= I_3;
        p0_transpose_item<1>(P.in[23], 1024, 1024, 1024, WO2T, scr, r, F.lane);
    }
    {
        const float* gq = P.in[6]; const float* gkv = P.in[7]; const float* wuq = P.in[8]; const float* wqi = P.in[9]; const float* wuv = P.in[10];
        for (int e = (int)blockIdx.x * 512 + F.tid; e < N2 * 256; e += F.G * 512) {
            const int n = e >> 8, k = e & 255; float v = 0.0f;
            if (n < 1024) { if (k < 128) v = gq[k] * wuq[(size_t)(k * 8 + (n >> 7)) * 128 + (n & 127)] * CQL; }
            else if (n < 1280) { const int j = n - 1024; if (k < 128) v = gq[k] * wqi[(size_t)(k * 8 + (j >> 5)) * 32 + (j & 31)]; }
            else if (n < 1408) { const int j = n - 1280; if (k == 128 + j) v = gkv[j]; }
            else if (n < 1920) { const int j = n - 1408; if (k >= 128) v = gkv[k - 128] * wuv[(size_t)((j >> 6) * 128 + (k - 128)) * 64 + (j & 63)]; }
            W2T[e] = (bf16)f2bf(v);
        }
    }
    __syncthreads();
    {
        LAS float* sl = (LAS float*)(F.lds + RING_OFF);
        LAS float* red = sl + 8192;
        const float* c = P.in[1]; const float* adaw = P.in[2]; const float* adab = P.in[3]; float* mods = (float*)(P.ws + WS_MODS);
        bool loaded = false;
        for (int it = (int)blockIdx.x; it < 96; it += F.G) {
            if (!loaded) { for (int i = F.tid; i < 8192; i += 512) sl[i] = silu_f(c[i]); loaded = true; __syncthreads(); }
            const int l = it / 48, n0 = (it % 48) * 64, col = F.tid & 63, kg = F.tid >> 6;
            float acc[8];
#pragma unroll
            for (int b = 0; b < 8; ++b) acc[b] = 0.0f;
            const float* wp = adaw + ((size_t)l * 1024 + kg * 128) * 3072 + n0 + col;
            for (int k = 0; k < 128; ++k) { const float w = wp[(size_t)k * 3072];
#pragma unroll
                for (int b = 0; b < 8; ++b) acc[b] += sl[b * 1024 + kg * 128 + k] * w; }
#pragma unroll
            for (int b = 0; b < 8; ++b) red[(kg * 8 + b) * 64 + col] = acc[b];
            __syncthreads();
            { const int b = F.tid >> 6; float s = 0.0f;
#pragma unroll
              for (int g2 = 0; g2 < 8; ++g2) s += red[(g2 * 8 + b) * 64 + col];
              mods[((size_t)l * 8 + b) * 3072 + n0 + col] = s + adab[l * 3072 + n0 + col]; }
            __syncthreads();
        }
    }
}

__device__ __forceinline__ void xn_phase(Frame& F, const float* xin, const float* g, const float* mods_l, bf16* XN) {
    const int gw = F.vcu * NWAVES + F.wave, NGW = F.G * NWAVES;
    for (int m = gw; m < M; m += NGW) {
        const int b = m >> 11;
        const GAS f32x4* xr = (const GAS f32x4*)(xin + (size_t)m * DM) + F.lane;
        f32x4 v[4]; float s = 0.f;
#pragma unroll
        for (int j = 0; j < 4; ++j) { v[j] = xr[64 * j]; s += (v[j].x * v[j].x + v[j].y * v[j].y) + (v[j].z * v[j].z + v[j].w * v[j].w); }
        const float rstd = 1.0f / sqrtf(wave_sum(s) * (1.0f / DM) + EPS);
        GAS unsigned long long* o8 = (GAS unsigned long long*)(XN + (size_t)m * DM) + F.lane;
#pragma unroll
        for (int j = 0; j < 4; ++j) { const int col = 4 * F.lane + 256 * j;
            const f32x4 gv = *(const f32x4*)(g + col), sc = *(const f32x4*)(mods_l + (size_t)b * 3072 + 1024 + col), sh = *(const f32x4*)(mods_l + (size_t)b * 3072 + col);
            const f32x4 h = v[j] * rstd * gv * (sc + 1.0f) + sh;
            o8[64 * j] = (unsigned long long)pk2(h.x, h.y) | ((unsigned long long)pk2(h.z, h.w) << 32); }
    }
}
__device__ __forceinline__ void final_norm_phase(Frame& F, float* x, const float* g) {
    const int gw = F.vcu * NWAVES + F.wave, NGW = F.G * NWAVES;
    for (int m = gw; m < M; m += NGW) {
        GAS f32x4* xr = (GAS f32x4*)(x + (size_t)m * DM) + F.lane;
        f32x4 v[4]; float s = 0.f;
#pragma unroll
        for (int j = 0; j < 4; ++j) { v[j] = xr[64 * j]; s += (v[j].x * v[j].x + v[j].y * v[j].y) + (v[j].z * v[j].z + v[j].w * v[j].w); }
        const float rstd = 1.0f / sqrtf(wave_sum(s) * (1.0f / DM) + EPS);
#pragma unroll
        for (int j = 0; j < 4; ++j) { const f32x4 gv = *(const f32x4*)(g + 4 * F.lane + 256 * j); xr[64 * j] = v[j] * rstd * gv; }
    }
}

__device__ __forceinline__ unsigned long long lowest_n_bits(unsigned long long e, int n) {
    unsigned long long r = 0ull;
    while (n > 0 && e) { const unsigned long long b = e & (0ull - e); r |= b; e ^= b; --n; }
    return r;
}
__device__ __forceinline__ unsigned long long topk_select(const unsigned (&keyv)[32], int lane) {
    unsigned T = 0u;
    for (int bit = 31; bit >= 0; --bit) {
        const unsigned cand = T | (1u << bit); int cnt = 0;
#pragma unroll
        for (int i = 0; i < 32; ++i) cnt += __popcll(__ballot(keyv[i] >= cand));
        if (cnt >= TOPK) T = cand;
    }
    int cgt = 0;
#pragma unroll
    for (int i = 0; i < 32; ++i) cgt += __popcll(__ballot(keyv[i] > T));
    int need = TOPK - cgt;
    unsigned long long mine = 0ull;
#pragma unroll
    for (int i = 0; i < 32; ++i) {
        const unsigned long long g = __ballot(keyv[i] > T), e = __ballot(keyv[i] == T);
        const int ne = __popcll(e);
        unsigned long long take;
        if (ne <= need) { take = e; need -= ne; } else { take = lowest_n_bits(e, need); need = 0; }
        const unsigned long long word = g | take;
        mine = (lane == i) ? word : mine;
    }
    return mine;
}
__device__ __forceinline__ unsigned sort_key(float v) { const unsigned u = __float_as_uint(v); return (u & 0x80000000u) ? ~u : (u | 0x80000000u); }

__device__ __forceinline__ void indexer_naive(Frame& F, const bf16* Y1, const bf16* QL, unsigned long long* MASK) {
    const int gw = F.vcu * NWAVES + F.wave, NGW = F.G * NWAVES, lane = F.lane;
    LAS float* qs = (LAS float*)(F.lds + RING_OFF + F.wave * 9216);
    LAS float* sc = qs + 256;
    for (int row = gw; row < M; row += NGW) {
        const int b = row >> 11, q = row & 2047;
        { const uint2 w2 = *(const uint2*)(QL + (size_t)row * N2 + QL_QIDX + 4 * lane);
          qs[4 * lane + 0] = bflo(w2.x); qs[4 * lane + 1] = bfhi(w2.x); qs[4 * lane + 2] = bflo(w2.y); qs[4 * lane + 3] = bfhi(w2.y); }
        float w[8];
        { const uint4 wv = *(const uint4*)(Y1 + (size_t)row * N1 + Y1_WIDX);
          w[0] = bflo(wv.x); w[1] = bfhi(wv.x); w[2] = bflo(wv.y); w[3] = bfhi(wv.y); w[4] = bflo(wv.z); w[5] = bfhi(wv.z); w[6] = bflo(wv.w); w[7] = bfhi(wv.w); }
        LDS_WAIT(); asm volatile("" ::: "memory");
        const int nw = (q >> 6) + 1;
        unsigned long long mine = 0ull;
        if (q + 1 <= TOPK) {
#pragma unroll
            for (int i = 0; i < 32; ++i) { const unsigned long long word = __ballot(64 * i + lane <= q); mine = (lane == i) ? word : mine; }
        } else {
            for (int i = 0; i < nw; ++i) {
                const int key = 64 * i + lane; float s = -INFINITY;
                if (key <= q) {
                    const uint4* kp = (const uint4*)(Y1 + (size_t)(b * SEQ + key) * N1 + Y1_KIDX);
                    float k[32];
#pragma unroll
                    for (int j = 0; j < 4; ++j) { const uint4 kv = kp[j];
                        k[8 * j + 0] = bflo(kv.x); k[8 * j + 1] = bfhi(kv.x); k[8 * j + 2] = bflo(kv.y); k[8 * j + 3] = bfhi(kv.y);
                        k[8 * j + 4] = bflo(kv.z); k[8 * j + 5] = bfhi(kv.z); k[8 * j + 6] = bflo(kv.w); k[8 * j + 7] = bfhi(kv.w); }
                    float acc = 0.0f;
#pragma unroll
                    for (int h = 0; h < 8; ++h) { float d = 0.0f;
#pragma unroll
                        for (int t = 0; t < 32; ++t) d += k[t] * qs[h * 32 + t];
                        acc += w[h] * fmaxf(d, 0.0f); }
                    s = acc + 0.0f;
                }
                sc[key] = s;
            }
            LDS_WAIT(); asm volatile("" ::: "memory");
            unsigned keyv[32];
#pragma unroll
            for (int i = 0; i < 32; ++i) { const float v = (i < nw) ? sc[64 * i + lane] : -INFINITY; keyv[i] = sort_key(v); }
            mine = topk_select(keyv, lane);
        }
        if (lane < 32) MASK[(size_t)row * 32 + lane] = mine;
        LDS_WAIT(); asm volatile("" ::: "memory");
    }
}

__device__ __forceinline__ void diffattn_naive(Frame& F, const Ptrs& P, const bf16* Y1, bf16* YC) {
    const int gw = F.vcu * NWAVES + F.wave, NGW = F.G * NWAVES, lane = F.lane, l5 = lane & 31;
    const float lam = __expf(wave_sum(P.in[11][lane] * P.in[12][lane])) - __expf(wave_sum(P.in[13][lane] * P.in[14][lane])) + LAM_INIT;
    const float* subg = P.in[15];
    for (int task = gw; task < M * 4; task += NGW) {
        const int row = task >> 2, h = task & 3, b = row >> 11, q = row & 2047;
        const unsigned qv = *(const unsigned*)(Y1 + (size_t)row * N1 + Y1_QA + 128 * h + 2 * lane);
        const float q0 = bflo(qv), q1 = bfhi(qv);
        const float slope2 = exp2f(-2.0f * (float)(h + 1)) * LOG2E;
        float m = -1e30f, l = 0.0f, o[4] = {0.f, 0.f, 0.f, 0.f};
        const bf16* Kb = Y1 + (size_t)(b * SEQ) * N1 + Y1_KA + 128 * h + 2 * lane;
        const bf16* Vb = Y1 + (size_t)(b * SEQ) * N1 + Y1_VA + 128 * h + 4 * l5;
        for (int k0 = 0; k0 <= q; k0 += 4) {
            unsigned kk[4]; uint2 vv[4];
#pragma unroll
            for (int j = 0; j < 4; ++j) { const int k = min(k0 + j, q); kk[j] = *(const unsigned*)(Kb + (size_t)k * N1); vv[j] = *(const uint2*)(Vb + (size_t)k * N1); }
#pragma unroll
            for (int j = 0; j < 4; ++j) {
                const int k = k0 + j;
                float part = q0 * bflo(kk[j]) + q1 * bfhi(kk[j]);
                part += __shfl_xor(part, 1); part += __shfl_xor(part, 2); part += __shfl_xor(part, 4); part += __shfl_xor(part, 8); part += __shfl_xor(part, 16);
                if (k <= q) {
                    const float s = part - slope2 * (float)(q - k);
                    const float mn = fmaxf(m, s), alpha = exp2f(m - mn), p = exp2f(s - mn);
                    l = l * alpha + p;
                    o[0] = o[0] * alpha + p * bflo(vv[j].x); o[1] = o[1] * alpha + p * bfhi(vv[j].x); o[2] = o[2] * alpha + p * bflo(vv[j].y); o[3] = o[3] * alpha + p * bfhi(vv[j].y);
                    m = mn;
                }
            }
        }
        const float il = 1.0f / l;
        float d[4]; float ss = 0.0f;
#pragma unroll
        for (int i = 0; i < 4; ++i) { const float mine = o[i] * il, other = __shfl_xor(mine, 32); d[i] = mine - lam * other; ss += d[i] * d[i]; }
        ss += __shfl_xor(ss, 1); ss += __shfl_xor(ss, 2); ss += __shfl_xor(ss, 4); ss += __shfl_xor(ss, 8); ss += __shfl_xor(ss, 16);
        const float rs = 1.0f / sqrtf(ss * (1.0f / 128.0f) + EPS) * (1.0f - LAM_INIT);
        if (lane < 32) {
            const uint2 gv = *(const uint2*)(Y1 + (size_t)row * N1 + Y1_GATE + 128 * h + 4 * l5);
            const float g0 = bflo(gv.x), g1 = bfhi(gv.x), g2 = bflo(gv.y), g3 = bfhi(gv.y);
            const float y0 = d[0] * rs * subg[4 * l5 + 0] * silu_f(g0), y1 = d[1] * rs * subg[4 * l5 + 1] * silu_f(g1), y2 = d[2] * rs * subg[4 * l5 + 2] * silu_f(g2), y3 = d[3] * rs * subg[4 * l5 + 3] * silu_f(g3);
            *(uint2*)(YC + (size_t)row * DM + 128 * h + 4 * l5) = make_uint2(pk2(y0, y1), pk2(y2, y3));
        }
    }
}

__device__ __forceinline__ void dsa_naive(Frame& F, const bf16* Y1, const bf16* QL, const unsigned long long* MASK, bf16* YC) {
    const int gw = F.vcu * NWAVES + F.wave, NGW = F.G * NWAVES, lane = F.lane, h = lane >> 3, j = lane & 7;
    const float slope2 = exp2f(-(float)(h + 1)) * LOG2E;
    for (int row = gw; row < M; row += NGW) {
        const int b = row >> 11, q = row & 2047;
        float qf[16];
        { const uint4* qp = (const uint4*)(QL + (size_t)row * N2 + 128 * h + 16 * j);
#pragma unroll
          for (int t = 0; t < 2; ++t) { const uint4 v = qp[t]; qf[8 * t + 0] = bflo(v.x); qf[8 * t + 1] = bfhi(v.x); qf[8 * t + 2] = bflo(v.y); qf[8 * t + 3] = bfhi(v.y); qf[8 * t + 4] = bflo(v.z); qf[8 * t + 5] = bfhi(v.z); qf[8 * t + 6] = bflo(v.w); qf[8 * t + 7] = bfhi(v.w); } }
        float m = -1e30f, l = 0.0f, o[8];
#pragma unroll
        for (int i = 0; i < 8; ++i) o[i] = 0.0f;
        const int nw = (q >> 6) + 1;
        for (int t = 0; t < nw; ++t) {
            const unsigned long long wraw = MASK[(size_t)row * 32 + t];
            unsigned long long w = ((unsigned long long)(unsigned)__builtin_amdgcn_readfirstlane((int)(wraw >> 32)) << 32) | (unsigned)__builtin_amdgcn_readfirstlane((int)(unsigned)wraw);
            while (w) {
                const int bit = __builtin_ctzll(w); w &= w - 1ull;
                const int k = 64 * t + bit; const bf16* kr = QL + (size_t)(b * SEQ + k) * N2;
                const uint4 ka = *(const uint4*)(kr + QL_KV + 16 * j), kb = *(const uint4*)(kr + QL_KV + 16 * j + 8);
                const uint4 vp = *(const uint4*)(kr + QL_VP + 64 * h + 8 * j);
                float part = qf[0] * bflo(ka.x) + qf[1] * bfhi(ka.x) + qf[2] * bflo(ka.y) + qf[3] * bfhi(ka.y) + qf[4] * bflo(ka.z) + qf[5] * bfhi(ka.z) + qf[6] * bflo(ka.w) + qf[7] * bfhi(ka.w)
                           + qf[8] * bflo(kb.x) + qf[9] * bfhi(kb.x) + qf[10] * bflo(kb.y) + qf[11] * bfhi(kb.y) + qf[12] * bflo(kb.z) + qf[13] * bfhi(kb.z) + qf[14] * bflo(kb.w) + qf[15] * bfhi(kb.w);
                part += __shfl_xor(part, 1); part += __shfl_xor(part, 2); part += __shfl_xor(part, 4);
                const float s = part - slope2 * (float)(q - k);
                const float mn = fmaxf(m, s), alpha = exp2f(m - mn), p = exp2f(s - mn);
                l = l * alpha + p; m = mn;
                o[0] = o[0] * alpha + p * bflo(vp.x); o[1] = o[1] * alpha + p * bfhi(vp.x); o[2] = o[2] * alpha + p * bflo(vp.y); o[3] = o[3] * alpha + p * bfhi(vp.y);
                o[4] = o[4] * alpha + p * bflo(vp.z); o[5] = o[5] * alpha + p * bfhi(vp.z); o[6] = o[6] * alpha + p * bflo(vp.w); o[7] = o[7] * alpha + p * bfhi(vp.w);
            }
        }
        const float il = 1.0f / l;
        const uint4 gv = *(const uint4*)(Y1 + (size_t)row * N1 + Y1_GATE + 512 + 64 * h + 8 * j);
        const float g[8] = {bflo(gv.x), bfhi(gv.x), bflo(gv.y), bfhi(gv.y), bflo(gv.z), bfhi(gv.z), bflo(gv.w), bfhi(gv.w)};
        float y[8];
#pragma unroll
        for (int i = 0; i < 8; ++i) y[i] = o[i] * il * silu_f(g[i]);
        *(uint4*)(YC + (size_t)row * DM + 512 + 64 * h + 8 * j) = make_uint4(pk2(y[0], y[1]), pk2(y[2], y[3]), pk2(y[4], y[5]), pk2(y[6], y[7]));
    }
}

__device__ __forceinline__ void swa_naive(Frame& F, const Ptrs& P, const bf16* Y2, bf16* YC) {
    const int gw = F.vcu * NWAVES + F.wave, NGW = F.G * NWAVES, lane = F.lane;
    LAS float* qs = (LAS float*)(F.lds + RING_OFF + F.wave * 1024);
    const float* sinks = P.in[18];
    for (int task = gw; task < M * 8; task += NGW) {
        const int row = task >> 3, head = task & 7, g = head >> 2, b = row >> 11, q = row & 2047;
        qs[lane] = bf2f(Y2[(size_t)row * N3 + 64 * head + lane]);
        LDS_WAIT(); asm volatile("" ::: "memory");
        const float slope2 = exp2f(-(float)(head + 1)) * LOG2E, sink2 = sinks[head] * LOG2E;
        float s2[2];
#pragma unroll
        for (int ds = 0; ds < 2; ++ds) {
            const int dist = lane + 64 * ds, k = q - dist; float s = -INFINITY;
            if (k >= 0) {
                const uint4* kp = (const uint4*)(Y2 + (size_t)(b * SEQ + k) * N3 + Y2_KC + 64 * g);
                float dot = 0.0f;
#pragma unroll
                for (int t = 0; t < 8; ++t) { const uint4 kv = kp[t];
                    dot += qs[8 * t + 0] * bflo(kv.x) + qs[8 * t + 1] * bfhi(kv.x) + qs[8 * t + 2] * bflo(kv.y) + qs[8 * t + 3] * bfhi(kv.y)
                         + qs[8 * t + 4] * bflo(kv.z) + qs[8 * t + 5] * bfhi(kv.z) + qs[8 * t + 6] * bflo(kv.w) + qs[8 * t + 7] * bfhi(kv.w); }
                s = dot - slope2 * (float)dist;
            }
            s2[ds] = s;
        }
        const float m = fmaxf(wave_max(fmaxf(s2[0], s2[1])), sink2);
        const float p0 = exp2f(s2[0] - m), p1 = exp2f(s2[1] - m);
        const float denom = wave_sum(p0 + p1) + exp2f(sink2 - m);
        float acc = 0.0f;
        const int nd = min(127, q);
        const bf16* vb = Y2 + (size_t)(b * SEQ) * N3 + Y2_VC + 64 * g + lane;
        for (int dist = 0; dist <= nd; ++dist) {
            const float p = (dist < 64) ? __shfl(p0, dist) : __shfl(p1, dist - 64);
            acc += p * bf2f(vb[(size_t)(q - dist) * N3]);
        }
        const float gt = bf2f(Y2[(size_t)row * N3 + Y2_GATE + 64 * head + lane]);
        YC[(size_t)row * DM + 64 * head + lane] = (bf16)f2bf(acc / denom * silu_f(gt));
        LDS_WAIT(); asm volatile("" ::: "memory");
    }
}

__device__ __forceinline__ void conv_phase(Frame& F, const Ptrs& P, const bf16* Y2, bf16* YC) {
    LAS float* CO = (LAS float*)(F.lds + RING_OFF);
    const float* dww = P.in[19]; const float* dwb = P.in[20]; const float* lng = P.in[21]; const float* lnb = P.in[22];
    const int c = F.tid;
    float wt[31];
#pragma unroll
    for (int j = 0; j < 31; ++j) wt[j] = dww[j * 512 + c];
    const float bias = dwb[c];
    for (int u = F.vcu; u < BATCH * 64; u += F.G) {
        const int b = u >> 6, t0 = (u & 63) * 32;
        float h[62];
#pragma unroll
        for (int r = 0; r < 62; ++r) { const int pos = t0 - 30 + r; float v = 0.0f;
            if (pos >= 0) { const bf16* rp = Y2 + (size_t)(b * SEQ + pos) * N3; const float val = bf2f(rp[Y2_DVAL + c]), gt = bf2f(rp[Y2_DGATE + c]); v = val / (1.0f + __expf(-gt)); }
            h[r] = v; }
#pragma unroll
        for (int t = 0; t < 32; ++t) { float a = bias;
#pragma unroll
            for (int j = 0; j < 31; ++j) a += wt[j] * h[t + j];
            CO[t * 512 + c] = a; }
        __syncthreads();
#pragma unroll
        for (int tt = 0; tt < 4; ++tt) { const int t = F.wave * 4 + tt, row = b * SEQ + t0 + t;
            float v[8]; float s = 0.0f;
#pragma unroll
            for (int i = 0; i < 8; ++i) { v[i] = CO[t * 512 + F.lane + 64 * i]; s += v[i]; }
            const float mu = wave_sum(s) * (1.0f / 512.0f); float s2 = 0.0f;
#pragma unroll
            for (int i = 0; i < 8; ++i) { v[i] -= mu; s2 += v[i] * v[i]; }
            const float rstd = 1.0f / sqrtf(wave_sum(s2) * (1.0f / 512.0f) + EPS);
#pragma unroll
            for (int i = 0; i < 8; ++i) { const int ch = F.lane + 64 * i; const float y = v[i] * rstd * lng[ch] + lnb[ch];
                const float gt = bf2f(Y2[(size_t)row * N3 + Y2_GATE + 512 + ch]);
                YC[(size_t)row * DM + 512 + ch] = (bf16)f2bf(silu_f(y) * silu_f(gt)); } }
        __syncthreads();
    }
}

#ifndef MK_PER_PHASE
#define MK_PER_PHASE 0
#endif
constexpr int N_PHASES = 12;
struct Args { const float* in[25]; float* out; unsigned char* ws; int ph_lo, ph_hi; };
static_assert(sizeof(Args) == 25 * 8 + 8 + 8 + 8, "Args has no padding");

__global__ void __launch_bounds__(NWAVES * 64, 2) mega_fwd(Args args) {
    extern __shared__ __attribute__((aligned(16))) unsigned char lds[];
    Frame F;
    F.lds = (LAS unsigned char*)lds;
    F.MISC = (volatile LAS unsigned*)(F.lds + MISC_OFF);
    F.tid = threadIdx.x; F.lane = F.tid & 63; F.wave = __builtin_amdgcn_readfirstlane(F.tid >> 6);
    F.G = gridDim.x; { const int bx = blockIdx.x; F.vcu = (F.G % 8 == 0) ? (bx % 8) * (F.G / 8) + bx / 8 : bx; }
    unsigned char* ws = args.ws;
    F.ctl = (gu32*)(ws + WS_CTL);
    Ptrs P;
#pragma unroll
    for (int i = 0; i < 25; ++i) P.in[i] = args.in[i];
    P.out = args.out; P.ws = ws;
    for (int u = F.tid; u < (LDS_BYTES - LDSCTL_OFF) / 4; u += NWAVES * 64) ((LAS unsigned*)(F.lds + LDSCTL_OFF))[u] = 0u;
    __syncthreads();
    XcdBarrier bar; bar.bar = (unsigned*)(F.ctl + CW_BAR); bar.x = 0; bar.st = nullptr;
    if (!MK_PER_PHASE) bar = xcd_barrier_post((unsigned*)(F.ctl + CW_BAR), F.MISC + 8);
#define GRID_BAR() do { if (!MK_PER_PHASE) xcd_barrier(bar); } while (0)
    const int lo = args.ph_lo, hi = args.ph_hi;
#define IN(k) (lo <= (k) && (k) < hi)
#define BOTH(k) (IN(k) && IN((k) + 1))

    bf16* W1T = (bf16*)(ws + WS_W1T); bf16* WO1T = (bf16*)(ws + WS_WO1T); bf16* W3T = (bf16*)(ws + WS_W3T); bf16* WO2T = (bf16*)(ws + WS_WO2T); bf16* W2T = (bf16*)(ws + WS_W2T);
    bf16* XN = (bf16*)(ws + WS_XN); bf16* Y1 = (bf16*)(ws + WS_Y1); bf16* QL = (bf16*)(ws + WS_QL); bf16* YC = (bf16*)(ws + WS_YC);
    unsigned long long* MASK = (unsigned long long*)(ws + WS_MASK);
    float* stats = (float*)(ws + WS_STATS); const float* mods = (const float*)(ws + WS_MODS);

    if (IN(0)) { p0_prologue(F, P); if (BOTH(0)) GRID_BAR(); }
    if (IN(1)) { xn_phase(F, P.in[0], P.in[4], mods, XN); if (BOTH(1)) GRID_BAR(); }
    if (IN(2)) {
        pg8::Gemm g{XN, W1T, M, N1, 1024, 1024, 1024}; pg8::StaticOrder S; S.init(M, N1, F.G, (int)blockIdx.x);
        pg8::EpiStoreBf16 E{Y1, N1, stats, 6};
        pg8::gemm_phase<pg8::EpiStoreBf16, pg8::StaticOrder, true, true>(F.lds + RING_OFF, g, S, E);
        if (BOTH(2)) GRID_BAR();
    }
    if (IN(3)) {
        pg8::Gemm g{Y1 + Y1_CQ, W2T, M, N2, 256, N1, 256}; pg8::StaticOrder S; S.init(M, N2, F.G, (int)blockIdx.x);
        pg8::EpiScaleBf16 E{QL, N2, stats, 5, EPS};
        pg8::gemm_phase<pg8::EpiScaleBf16, pg8::StaticOrder, true, true>(F.lds + RING_OFF, g, S, E);
        if (BOTH(3)) GRID_BAR();
    }
    if (IN(4)) { indexer_naive(F, Y1, QL, MASK); if (BOTH(4)) GRID_BAR(); }
    if (IN(5)) { diffattn_naive(F, P, Y1, YC); dsa_naive(F, Y1, QL, MASK, YC); if (BOTH(5)) GRID_BAR(); }
    if (IN(6)) {
        pg8::Gemm g{YC, WO1T, M, 1024, 1024, 1024, 1024}; pg8::StaticOrder S; S.init(M, 1024, F.G, (int)blockIdx.x);
        pg8::EpiResid E{P.in[0], P.out, mods + 2048, 3072};
        pg8::gemm_phase<pg8::EpiResid, pg8::StaticOrder, false, true>(F.lds + RING_OFF, g, S, E);
        if (BOTH(6)) GRID_BAR();
    }
    if (IN(7)) { xn_phase(F, P.out, P.in[4] + 1024, mods + 8 * 3072, XN); if (BOTH(7)) GRID_BAR(); }
    if (IN(8)) {
        pg8::Gemm g{XN, W3T, M, N3, 1024, 1024, 1024}; pg8::StaticOrder S; S.init(M, N3, F.G, (int)blockIdx.x);
        pg8::EpiStoreBf16 E{Y1, N3, nullptr, -1};
        pg8::gemm_phase<pg8::EpiStoreBf16, pg8::StaticOrder, true, true>(F.lds + RING_OFF, g, S, E);
        if (BOTH(8)) GRID_BAR();
    }
    if (IN(9)) { swa_naive(F, P, Y1, YC); __syncthreads(); conv_phase(F, P, Y1, YC); if (BOTH(9)) GRID_BAR(); }
    if (IN(10)) {
        pg8::Gemm g{YC, WO2T, M, 1024, 1024, 1024, 1024}; pg8::StaticOrder S; S.init(M, 1024, F.G, (int)blockIdx.x);
        pg8::EpiResid E{P.out, P.out, mods + 8 * 3072 + 2048, 3072};
        pg8::gemm_phase<pg8::EpiResid, pg8::StaticOrder, false, true>(F.lds + RING_OFF, g, S, E);
        if (BOTH(10)) GRID_BAR();
    }
    if (IN(11)) { final_norm_phase(F, P.out, P.in[24]); }
#undef IN
#undef BOTH
}

extern "C" void kernel_launch(void* const* d_in, const int* in_sizes, int n_in, void* d_out, int out_size, void* d_ws, size_t ws_size, hipStream_t stream) {
    static int grid = 0;
    if (grid == 0) {
        if (n_in != 25 || in_sizes[0] != M * DM || out_size != M * DM || ws_size < WS_END) { fprintf(stderr, "kernel_launch: unexpected shapes (n_in %d, in0 %d, out %d, ws %zu); nothing launched\n", n_in, n_in > 0 ? in_sizes[0] : -1, out_size, ws_size); grid = -1; return; }
        int dev = 0, cus = 0, per_cu = 0;
        if (hipGetDevice(&dev) != hipSuccess || hipDeviceGetAttribute(&cus, hipDeviceAttributeMultiprocessorCount, dev) != hipSuccess) { grid = -1; return; }
        if (hipFuncSetAttribute((const void*)mega_fwd, hipFuncAttributeMaxDynamicSharedMemorySize, LDS_BYTES) != hipSuccess) { fprintf(stderr, "kernel_launch: hipFuncSetAttribute failed\n"); grid = -1; return; }
        if (hipOccupancyMaxActiveBlocksPerMultiprocessor(&per_cu, (const void*)mega_fwd, NWAVES * 64, LDS_BYTES) != hipSuccess || per_cu < 1)
            fprintf(stderr, "kernel_launch: note: occupancy query reports %d workgroups per CU\n", per_cu);
        (void)hipGetLastError();
        grid = cus;
    }
    if (grid < 0) return;
    if (hipMemsetAsync((char*)d_ws + WS_CTL, 0, CTL_ZERO_BYTES, stream) != hipSuccess) { fprintf(stderr, "kernel_launch: hipMemsetAsync failed\n"); return; }
    Args a{};
    for (int i = 0; i < 25; ++i) a.in[i] = (const float*)d_in[i];
    a.out = (float*)d_out; a.ws = (unsigned char*)d_ws;
#if MK_PER_PHASE
    for (int ph = 0; ph < N_PHASES; ++ph) { a.ph_lo = ph; a.ph_hi = ph + 1; hipLaunchKernelGGL(mega_fwd, dim3(grid), dim3(NWAVES * 64), LDS_BYTES, stream, a); }
#else
    a.ph_lo = 0; a.ph_hi = N_PHASES;
    hipLaunchKernelGGL(mega_fwd, dim3(grid), dim3(NWAVES * 64), LDS_BYTES, stream, a);
#endif
    const hipError_t le = hipPeekAtLastError();
    if (le != hipSuccess) fprintf(stderr, "kernel_launch: launch failed: %s\n", hipGetErrorName(le));
}
```

```cpp
#include <hip/hip_runtime.h>
#include <cstdio>
#include <cstdint>
namespace pg8 {
#define PG8_LAS __attribute__((address_space(3)))
typedef unsigned short bf16_t;
typedef short bf16x8 __attribute__((ext_vector_type(8)));
typedef float f32x4 __attribute__((ext_vector_type(4)));
typedef unsigned u32x4 __attribute__((ext_vector_type(4)));
constexpr int BM = 256, BK = 64, HALF = 128, HTB = HALF * BK * 2  , STAGE_BYTES = 8 * HTB, NXCD = 8, WGM = 8;

__host__ __device__ __forceinline__ int lds_byte(int r, int c) { const int st = (r >> 4) * 2 + (c >> 5), rr = r & 15, cc = c & 31, ob = rr * 64 + cc * 2; return st * 1024 + (ob ^ (((ob >> 9) & 1) << 5)); }
__host__ __device__ __forceinline__ void stage_rc(int b, int& R, int& C) { const int st = b / 1024, sb = b % 1024, swz = sb ^ (((sb >> 9) & 1) << 5); R = (st >> 1) * 16 + swz / 64; C = (st & 1) * 32 + (swz % 64) / 2; }
__host__ __device__ __forceinline__ int perm32(int rho) { const int n = rho >> 4, i = rho & 15; return 8 * (i >> 2) + 4 * n + (i & 3); }

struct Unit { int pm, pn; };
struct Gemm { const bf16_t* A; const bf16_t* Bt; int M, N, K, lda, ldb; };

struct StaticOrder {
    int nM, nN, nwg, G, c;
    __host__ __device__ void init(int M, int N, int G_, int c_) { nM = M / BM; nN = N / BM; nwg = nM * nN; G = G_; c = c_; }
    __host__ __device__ bool next(int i, Unit& u) const {
        const long L = (long)i * G + c; if (L >= nwg) return false;
        int wgid = (int)L; { const int q = nwg / NXCD, r = nwg % NXCD, xcd = wgid % NXCD, off = wgid / NXCD; wgid = (xcd < r ? xcd * (q + 1) : r * (q + 1) + (xcd - r) * q) + off; }
        const int nig = WGM * nN, gid = wgid / nig, fm = gid * WGM, gsz = (nM - fm) < WGM ? (nM - fm) : WGM;
        u.pm = fm + ((wgid % nig) % gsz); u.pn = (wgid % nig) / gsz; return true;
    }
    __device__ __forceinline__ void a_ready(const Unit&) const {}
    __device__ __forceinline__ void done(const Unit&) const {}
};

__device__ __forceinline__ unsigned cvt_pk_bf16(float lo, float hi) { unsigned r; asm volatile("v_cvt_pk_bf16_f32 %0, %1, %2" : "=v"(r) : "v"(lo), "v"(hi)); return r; }

struct EpiStoreBf16 {
    static constexpr bool PERM = true, AFTER_DRAIN = false;
    bf16_t* O; int ldc; float* stats; int stat_pn;
    __device__ __forceinline__ void operator()(const f32x4 (&acc)[2][2][4][2], const Unit& u, int wr, int wc, int fr, int fq) const {
        const int row0 = u.pm * BM + wr * 64 + fr, col0 = u.pn * BM + wc * 32 + 8 * fq;
#pragma unroll
        for (int ai = 0; ai < 2; ++ai)
#pragma unroll
            for (int m = 0; m < 4; ++m) { bf16_t* rowp = O + (size_t)(row0 + ai * HALF + m * 16) * ldc + col0;
#pragma unroll
                for (int bj = 0; bj < 2; ++bj) { const f32x4 v0 = acc[ai][bj][m][0], v1 = acc[ai][bj][m][1];
                    u32x4 w; w.x = cvt_pk_bf16(v0[0], v0[1]); w.y = cvt_pk_bf16(v0[2], v0[3]); w.z = cvt_pk_bf16(v1[0], v1[1]); w.w = cvt_pk_bf16(v1[2], v1[3]);
                    *(u32x4*)(rowp + bj * HALF) = w; } }
        if (stats != nullptr && u.pn == stat_pn) {
#pragma unroll
            for (int ai = 0; ai < 2; ++ai)
#pragma unroll
                for (int m = 0; m < 4; ++m)
#pragma unroll
                    for (int bj = 0; bj < 2; ++bj) { const f32x4 v0 = acc[ai][bj][m][0], v1 = acc[ai][bj][m][1];
                        float s = (v0[0] * v0[0] + v0[1] * v0[1]) + (v0[2] * v0[2] + v0[3] * v0[3]) + (v1[0] * v1[0] + v1[1] * v1[1]) + (v1[2] * v1[2] + v1[3] * v1[3]);
                        s += __shfl_xor(s, 16); s += __shfl_xor(s, 32);
                        if (fq == 0) atomicAdd(stats + (size_t)(row0 + ai * HALF + m * 16) * 2 + bj, s); }
        }
    }
};
struct EpiScaleBf16 {
    static constexpr bool PERM = true, AFTER_DRAIN = false;
    bf16_t* O; int ldc; const float* stats; int pn_split; float eps;
    __device__ __forceinline__ void operator()(const f32x4 (&acc)[2][2][4][2], const Unit& u, int wr, int wc, int fr, int fq) const {
        const int row0 = u.pm * BM + wr * 64 + fr, col0 = u.pn * BM + wc * 32 + 8 * fq, si = (u.pn < pn_split) ? 0 : 1;
#pragma unroll
        for (int ai = 0; ai < 2; ++ai)
#pragma unroll
            for (int m = 0; m < 4; ++m) { const int row = row0 + ai * HALF + m * 16; bf16_t* rowp = O + (size_t)row * ldc + col0;
                const float rs = 1.0f / sqrtf(stats[(size_t)row * 2 + si] * (1.0f / 128.0f) + eps);
#pragma unroll
                for (int bj = 0; bj < 2; ++bj) { const f32x4 v0 = acc[ai][bj][m][0] * rs, v1 = acc[ai][bj][m][1] * rs;
                    u32x4 w; w.x = cvt_pk_bf16(v0[0], v0[1]); w.y = cvt_pk_bf16(v0[2], v0[3]); w.z = cvt_pk_bf16(v1[0], v1[1]); w.w = cvt_pk_bf16(v1[2], v1[3]);
                    *(u32x4*)(rowp + bj * HALF) = w; } }
    }
};
struct EpiResid {
    static constexpr bool PERM = false, AFTER_DRAIN = false;
    const float* resid; float* out; const float* gate; int gstride;
    __device__ __forceinline__ void operator()(const f32x4 (&acc)[2][2][4][2], const Unit& u, int wr, int wc, int fr, int fq) const {
        const int row0 = u.pm * BM + wr * 64 + fr, col0 = u.pn * BM + wc * 32 + 4 * fq;
        const float* gp = gate + (size_t)(u.pm >> 3) * gstride + col0;
        f32x4 gv[2][2];
#pragma unroll
        for (int bj = 0; bj < 2; ++bj)
#pragma unroll
            for (int n = 0; n < 2; ++n) gv[bj][n] = *(const f32x4*)(gp + bj * HALF + n * 16);
#pragma unroll
        for (int ai = 0; ai < 2; ++ai)
#pragma unroll
            for (int m = 0; m < 4; ++m) { const size_t off = (size_t)(row0 + ai * HALF + m * 16) * 1024 + col0;
#pragma unroll
                for (int bj = 0; bj < 2; ++bj)
#pragma unroll
                    for (int n = 0; n < 2; ++n) { const f32x4 r = *(const f32x4*)(resid + off + bj * HALF + n * 16); *(f32x4*)(out + off + bj * HALF + n * 16) = r + gv[bj][n] * acc[ai][bj][m][n]; }
                if (m & 1) asm volatile("" ::: "memory"); }
    }
};

template <class Epi, class Sched, bool ALIGN_EPI = false, bool SP2 = false>
__device__ __forceinline__ void gemm_phase(PG8_LAS unsigned char* lds, const Gemm g, const Sched& S, const Epi& E) {
    const int tid = threadIdx.x, wid = __builtin_amdgcn_readfirstlane(tid >> 6), lane = tid & 63, wr = wid >> 2, wc = wid & 3, fr = lane & 15, fq = lane >> 4;
    const int K = g.K, nt = K / BK;
    unsigned voffA[2], voffB[2];
#pragma unroll
    for (int i = 0; i < 2; ++i) { int R, C; stage_rc(tid * 16 + i * 8192, R, C); const int Rb = Epi::PERM ? ((R & ~31) + perm32(R & 31)) : R;
        voffA[i] = (unsigned)(R * g.lda + C) * 2u; voffB[i] = (unsigned)(Rb * g.ldb + C) * 2u; }
    const size_t kstep = (size_t)(BK * 2);
    const size_t hstepA = (size_t)HALF * g.lda * 2, hstepB = (size_t)HALF * g.ldb * 2;
    const size_t tstepA = 2 * hstepA, tstepB = 2 * hstepB;
    const unsigned ldsw = (unsigned)wid * 1024u;
    const int aoff = lds_byte(wr * 64 + fr, fq * 8), boff = lds_byte(wc * 32 + fr, fq * 8);
#define PG8_SA(b, h) (((b) * 2 + (h)) * HTB)
#define PG8_SB(b, h) ((4 + (b) * 2 + (h)) * HTB)
#define PG8_STAGE(bufoff, gbase, voff) do { _Pragma("unroll") for (int _i = 0; _i < 2; ++_i) \
        __builtin_amdgcn_global_load_lds((const unsigned*)((const char*)(gbase) + (voff)[_i]), (PG8_LAS unsigned*)(lds + (bufoff) + ldsw + _i * 8192), 16, 0, 0); } while (0)
#define PG8_LDA(dst, b, h) do { _Pragma("unroll") for (int m = 0; m < 4; ++m) _Pragma("unroll") for (int k = 0; k < 2; ++k) dst[m][k] = *(const PG8_LAS bf16x8*)(lds + PG8_SA(b, h) + aoff + m * 2048 + k * 1024); } while (0)
#define PG8_LDB(dst, b, h) do { _Pragma("unroll") for (int n = 0; n < 2; ++n) _Pragma("unroll") for (int k = 0; k < 2; ++k) dst[n][k] = *(const PG8_LAS bf16x8*)(lds + PG8_SB(b, h) + boff + n * 2048 + k * 1024); } while (0)
#define PG8_MMA(ai, bj, At, Bt) do { __builtin_amdgcn_s_setprio(1); _Pragma("unroll") for (int m = 0; m < 4; ++m) _Pragma("unroll") for (int n = 0; n < 2; ++n) _Pragma("unroll") for (int k = 0; k < 2; ++k) \
        acc[ai][bj][m][n] = __builtin_amdgcn_mfma_f32_16x16x32_bf16(Bt[n][k], At[m][k], acc[ai][bj][m][n], 0, 0, 0); __builtin_amdgcn_s_setprio(0); } while (0)
#define PG8_WAIT_V(n) asm volatile("s_waitcnt vmcnt(" #n ")" ::: "memory")
#define PG8_WAIT_L(n) asm volatile("s_waitcnt lgkmcnt(" #n ")" ::: "memory")
#define PG8_BAR __builtin_amdgcn_s_barrier()
#define PG8_SCHED __builtin_amdgcn_sched_barrier(0)
    Unit cur, nxt; int ui = 0;
    if (!S.next(0, cur)) return;
    f32x4 acc[2][2][4][2];
#pragma unroll
    for (int a = 0; a < 2; ++a)
#pragma unroll
        for (int b = 0; b < 2; ++b)
#pragma unroll
            for (int m = 0; m < 4; ++m)
#pragma unroll
                for (int n = 0; n < 2; ++n) acc[a][b][m][n] = (f32x4){0.f, 0.f, 0.f, 0.f};
    bf16x8 At[4][2], B0[2][2], B1[2][2];
    const char* cA = (const char*)g.A + (size_t)cur.pm * tstepA; const char* cB = (const char*)g.Bt + (size_t)cur.pn * tstepB;
    S.a_ready(cur);
    if constexpr (SP2) {
        PG8_STAGE(PG8_SB(0, 0), cB, voffB); PG8_STAGE(PG8_SB(0, 1), cB + hstepB, voffB); PG8_STAGE(PG8_SA(0, 0), cA, voffA); PG8_STAGE(PG8_SA(0, 1), cA + hstepA, voffA);
        if (wr == 1) PG8_BAR;
        PG8_WAIT_V(2); PG8_BAR;
        PG8_STAGE(PG8_SB(1, 0), cB + kstep, voffB); PG8_STAGE(PG8_SA(1, 0), cA + kstep, voffA); PG8_STAGE(PG8_SB(1, 1), cB + hstepB + kstep, voffB);
        PG8_WAIT_V(6); PG8_BAR;
    } else {
        PG8_STAGE(PG8_SB(0, 0), cB, voffB); PG8_STAGE(PG8_SA(0, 0), cA, voffA); PG8_STAGE(PG8_SB(0, 1), cB + hstepB, voffB); PG8_STAGE(PG8_SA(0, 1), cA + hstepA, voffA);
        if (wr == 1) PG8_BAR;
        PG8_WAIT_V(4); PG8_BAR;
        PG8_STAGE(PG8_SB(1, 0), cB + kstep, voffB); PG8_STAGE(PG8_SA(1, 0), cA + kstep, voffA); PG8_STAGE(PG8_SB(1, 1), cB + hstepB + kstep, voffB);
        PG8_WAIT_V(6); PG8_BAR;
    }
    for (;;) {
        const bool has_next = S.next(ui + 1, nxt);
        const char* nA = has_next ? (const char*)g.A + (size_t)nxt.pm * tstepA : cA; const char* nB = has_next ? (const char*)g.Bt + (size_t)nxt.pn * tstepB : cB;
        for (int t = 0; t < nt; t += 2) {
            const bool last = (t == nt - 2);
            const char* a1 = cA + (size_t)(t + 1) * kstep;
            const char* a2 = last ? nA : cA + (size_t)(t + 2) * kstep; const char* b2 = last ? nB : cB + (size_t)(t + 2) * kstep;
            const char* a3 = a2 + kstep; const char* b3 = b2 + kstep;
            if (last && has_next) S.a_ready(nxt);
            if constexpr (SP2) {
            PG8_LDB(B0, 0, 0); PG8_LDB(B1, 0, 1); PG8_SCHED; PG8_LDA(At, 0, 0); PG8_STAGE(PG8_SA(1, 1), a1 + hstepA, voffA);
            PG8_WAIT_V(8); PG8_WAIT_L(0); PG8_BAR; PG8_MMA(0, 0, At, B0); PG8_MMA(0, 1, At, B1); PG8_BAR; PG8_SCHED;
            PG8_LDA(At, 0, 1); PG8_STAGE(PG8_SB(0, 0), b2, voffB); PG8_STAGE(PG8_SB(0, 1), b2 + hstepB, voffB); PG8_STAGE(PG8_SA(0, 0), a2, voffA);
            PG8_WAIT_V(8); PG8_WAIT_L(0); PG8_BAR; PG8_MMA(1, 0, At, B0); PG8_MMA(1, 1, At, B1); PG8_BAR; PG8_SCHED;
            PG8_LDB(B0, 1, 0); PG8_LDB(B1, 1, 1); PG8_SCHED; PG8_LDA(At, 1, 0); PG8_STAGE(PG8_SA(0, 1), a2 + hstepA, voffA);
            PG8_WAIT_V(8); PG8_WAIT_L(0); PG8_BAR; PG8_MMA(0, 0, At, B0); PG8_MMA(0, 1, At, B1); PG8_BAR; PG8_SCHED;
            PG8_LDA(At, 1, 1); PG8_STAGE(PG8_SB(1, 0), b3, voffB); PG8_STAGE(PG8_SB(1, 1), b3 + hstepB, voffB); PG8_STAGE(PG8_SA(1, 0), a3, voffA);
            PG8_WAIT_V(8); PG8_WAIT_L(0); PG8_BAR; PG8_MMA(1, 0, At, B0); PG8_MMA(1, 1, At, B1); PG8_BAR; PG8_SCHED;
            } else {
            PG8_LDB(B0, 0, 0); PG8_SCHED; PG8_LDA(At, 0, 0); PG8_STAGE(PG8_SA(1, 1), a1 + hstepA, voffA);
            PG8_WAIT_L(8); PG8_BAR; PG8_WAIT_L(0); PG8_MMA(0, 0, At, B0); PG8_BAR; PG8_SCHED;
            PG8_LDB(B1, 0, 1); PG8_STAGE(PG8_SB(0, 0), b2, voffB);
            PG8_BAR; PG8_WAIT_L(0); PG8_MMA(0, 1, At, B1); PG8_BAR;
            PG8_LDA(At, 0, 1); PG8_STAGE(PG8_SA(0, 0), a2, voffA);
            PG8_BAR; PG8_WAIT_L(0); PG8_MMA(1, 0, At, B0); PG8_BAR; PG8_SCHED;
            PG8_STAGE(PG8_SB(0, 1), b2 + hstepB, voffB);
            PG8_WAIT_V(6); PG8_BAR; PG8_MMA(1, 1, At, B1); PG8_BAR;
            PG8_LDB(B0, 1, 0); PG8_SCHED; PG8_LDA(At, 1, 0); PG8_STAGE(PG8_SA(0, 1), a2 + hstepA, voffA);
            PG8_WAIT_L(8); PG8_BAR; PG8_WAIT_L(0); PG8_MMA(0, 0, At, B0); PG8_BAR; PG8_SCHED;
            PG8_LDB(B1, 1, 1); PG8_STAGE(PG8_SB(1, 0), b3, voffB);
            PG8_BAR; PG8_WAIT_L(0); PG8_MMA(0, 1, At, B1); PG8_BAR;
            PG8_LDA(At, 1, 1); PG8_STAGE(PG8_SA(1, 0), a3, voffA);
            PG8_BAR; PG8_WAIT_L(0); PG8_MMA(1, 0, At, B0); PG8_BAR; PG8_SCHED;
            PG8_STAGE(PG8_SB(1, 1), b3 + hstepB, voffB);
            PG8_WAIT_V(6); PG8_BAR; PG8_MMA(1, 1, At, B1); PG8_BAR;
            }
        }
        if constexpr (ALIGN_EPI) { if (wr == 0) PG8_BAR; }
        if constexpr (!Epi::AFTER_DRAIN) { E(acc, cur, wr, wc, fr, fq); S.done(cur); }
        if (!has_next) break;
#pragma unroll
        for (int a = 0; a < 2; ++a)
#pragma unroll
            for (int b = 0; b < 2; ++b)
#pragma unroll
                for (int m = 0; m < 4; ++m)
#pragma unroll
                    for (int n = 0; n < 2; ++n) acc[a][b][m][n] = (f32x4){0.f, 0.f, 0.f, 0.f};
        cur = nxt; cA = nA; cB = nB; ++ui;
        if constexpr (ALIGN_EPI) { if (wr == 1) PG8_BAR; }
    }
    PG8_WAIT_V(0);
    if constexpr (!ALIGN_EPI) { if (wr == 0) PG8_BAR; }
    PG8_BAR;
    if constexpr (Epi::AFTER_DRAIN) { E.fused(acc, cur, wr, wc, fr, fq, lds, wid, lane); S.done(cur); }
#undef PG8_SA
#undef PG8_SB
#undef PG8_STAGE
#undef PG8_LDA
#undef PG8_LDB
#undef PG8_MMA
#undef PG8_WAIT_V
#undef PG8_WAIT_L
#undef PG8_BAR
#undef PG8_SCHED
}
}

constexpr int NWAVES = 8;
constexpr int BATCH = 8, SEQ = 2048, DM = 1024, M = BATCH * SEQ;
constexpr int N1 = 3072;
constexpr int N1SRC = 2856;
constexpr int Y1_QA = 0, Y1_KA = 512, Y1_VA = 1024, Y1_CQ = 1536, Y1_KIDX = 1792, Y1_WIDX = 1824, Y1_GATE = 2048;
constexpr int N2 = 2048;
constexpr int QL_QIDX = 1024, QL_KV = 1280, QL_VP = 1408;
constexpr int N3 = 2816;
constexpr int Y2_KC = 512, Y2_VC = 640, Y2_DVAL = 768, Y2_DGATE = 1280, Y2_GATE = 1792;
constexpr float EPS = 1e-6f, LOG2E = 1.4426950408889634f;
constexpr float CQK = 0.125f * LOG2E;
constexpr float CQL = 0.08838834764831845f * LOG2E;
constexpr float LAM_INIT = 0.2f;
constexpr int TOPK = 256;

constexpr size_t MiB = 1u << 20;
constexpr size_t WS_CTL = 0, CTL_ZERO_BYTES = 1 * MiB;
constexpr size_t WS_STATS = 512 * 1024;
constexpr size_t WS_MODS = 1 * MiB;
constexpr size_t WS_W1T = 2 * MiB;
constexpr size_t WS_WO1T = 8 * MiB;
constexpr size_t WS_W3T = 10 * MiB;
constexpr size_t WS_WO2T = 16 * MiB;
constexpr size_t WS_W2T = 18 * MiB;
constexpr size_t WS_XN = 20 * MiB;
constexpr size_t WS_Y1 = 52 * MiB;
constexpr size_t WS_QL = 148 * MiB;
constexpr size_t WS_YC = 212 * MiB;
constexpr size_t WS_MASK = 244 * MiB;
constexpr size_t WS_END = 248 * MiB;
constexpr int CW_BAR = 4096;

constexpr int RING_OFF = 0, RING_BYTES = 131072;
constexpr int LDSCTL_OFF = RING_BYTES, MISC_OFF = LDSCTL_OFF + 320;
constexpr int LDS_BYTES = 147456;

#define GAS __attribute__((address_space(1)))
#define LAS __attribute__((address_space(3)))
typedef unsigned short bf16;
typedef unsigned v4u __attribute__((ext_vector_type(4)));
typedef float f32x4 __attribute__((ext_vector_type(4)));
typedef short bf16x8 __attribute__((ext_vector_type(8)));
typedef GAS unsigned gu32;
typedef GAS unsigned long long gu64;
#define RLX_AGENT __ATOMIC_RELAXED, __HIP_MEMORY_SCOPE_AGENT
#define LDS_WAIT() asm volatile("s_waitcnt lgkmcnt(0)" ::: "memory")
#define VM_WAIT() asm volatile("s_waitcnt vmcnt(0)" ::: "memory")
__device__ __forceinline__ unsigned long long rt() { return __builtin_amdgcn_s_memrealtime(); }
__device__ __forceinline__ unsigned f2bf(float f) { unsigned u = __builtin_bit_cast(unsigned, f); return (u + 0x7fffu + ((u >> 16) & 1u)) >> 16; }
__device__ __forceinline__ unsigned pk2(float lo, float hi) { return f2bf(lo) | (f2bf(hi) << 16); }

#define XB_TMO      128
#define XB_XCNT(j)  (256  + 64 * (j))
#define XB_XSUB(j)  (1280 + 64 * (j))
#define XB_XGEN(j)  (2304 + 64 * (j))
#define XB_TOP      3328
#define XB_TOPGEN   3392
#define XCD_BAR_WORDS 3456
#define XB_SPIN_CAP (1u << 18)

__device__ __forceinline__ unsigned xb_ld(unsigned* p)              { return __hip_atomic_load(p, __ATOMIC_RELAXED, __HIP_MEMORY_SCOPE_AGENT); }
__device__ __forceinline__ unsigned xb_add(unsigned* p, unsigned v) { return __hip_atomic_fetch_add(p, v, __ATOMIC_RELAXED, __HIP_MEMORY_SCOPE_AGENT); }
__device__ __forceinline__ unsigned xb_xcc_id() { return (unsigned)__builtin_amdgcn_s_getreg((3 << 11) | 20) & 0xFu; }
#define XB_SPIN(cond, bar) do { unsigned _sp = 0; while (cond) { __builtin_amdgcn_s_sleep(1); \
    if ((++_sp & 255u) == 0u) { if (xb_ld(&(bar)[XB_TMO])) break; if (_sp > XB_SPIN_CAP) { atomicAdd(&(bar)[XB_TMO], 1u); break; } } } } while (0)

struct XcdBarrier {
    unsigned* bar; unsigned x;
    volatile LAS unsigned* st;
};

__device__ __forceinline__ XcdBarrier xcd_barrier_post(unsigned* bar, volatile LAS unsigned* st) {
    XcdBarrier b; b.bar = bar; b.x = xb_xcc_id(); b.st = st;
    if (threadIdx.x == 0) (void)xb_add(&bar[XB_XCNT(b.x)], 1u);
    return b;
}
__device__ __forceinline__ void xcd_barrier_complete(unsigned* bar, unsigned x, unsigned& nloc, unsigned& nx) {
    const unsigned G = gridDim.x * gridDim.y * gridDim.z;
    unsigned sum, cnt, mine, sp = 0u;
    for (;;) {
        sum = 0u; cnt = 0u; mine = 0u;
#pragma unroll
        for (unsigned j = 0; j < 16; ++j) { const unsigned c = xb_ld(&bar[XB_XCNT(j)]); sum += c; cnt += (c > 0u) ? 1u : 0u; mine = (j == x) ? c : mine; }
        if (sum == G) break;
        __builtin_amdgcn_s_sleep(1);
        if ((++sp & 255u) == 0u) { if (xb_ld(&bar[XB_TMO])) break; if (sp > XB_SPIN_CAP) { atomicAdd(&bar[XB_TMO], 1u); break; } }
    }
    nloc = mine > 0u ? mine : 1u; nx = cnt > 0u ? cnt : 1u;
}

__device__ __forceinline__ void xcd_barrier(const XcdBarrier& b) {
    asm volatile("s_waitcnt vmcnt(0)" ::: "memory");
    __syncthreads();
    if (threadIdx.x == 0) {
        unsigned* bar = b.bar;
        __builtin_amdgcn_s_waitcnt(0);
        unsigned nloc = b.st[0], nx = b.st[1];
        if (nloc == 0u) { xcd_barrier_complete(bar, b.x, nloc, nx); b.st[0] = nloc; b.st[1] = nx; }
        const unsigned old = xb_add(&bar[XB_XSUB(b.x)], 1u);
        const unsigned gen = old / nloc;
        if (old + 1u == (gen + 1u) * nloc) {
            __builtin_amdgcn_fence(__ATOMIC_RELEASE, "agent");
            asm volatile("s_waitcnt vmcnt(0)" ::: "memory");
            const unsigned og = xb_add(&bar[XB_TOP], 1u);
            const unsigned tg = og / nx;
            if (og + 1u == (tg + 1u) * nx) xb_add(&bar[XB_TOPGEN], 1u);
            else XB_SPIN(xb_ld(&bar[XB_TOPGEN]) == tg, bar);
            __builtin_amdgcn_fence(__ATOMIC_ACQUIRE, "agent");
            xb_add(&bar[XB_XGEN(b.x)], 1u);
            asm volatile("s_waitcnt vmcnt(0)" ::: "memory");
        } else {
            XB_SPIN(xb_ld(&bar[XB_XGEN(b.x)]) == gen, bar);
            __builtin_amdgcn_fence(__ATOMIC_ACQUIRE, "agent");
            asm volatile("s_waitcnt vmcnt(0)" ::: "memory");
        }
    }
    __syncthreads();
}


struct Frame {
    LAS unsigned char* lds;
    volatile LAS unsigned* MISC;
    gu32* ctl;
    int tid, lane, wave;
    int vcu, G;
};
__device__ __forceinline__ float wave_sum(float v) {
#pragma unroll
    for (int o = 1; o < 64; o <<= 1) v += __shfl_xor(v, o);
    return v;
}
__device__ __forceinline__ float wave_max(float v) {
#pragma unroll
    for (int o = 1; o < 64; o <<= 1) v = fmaxf(v, __shfl_xor(v, o));
    return v;
}
__device__ __forceinline__ float bflo(unsigned w) { return __uint_as_float(w << 16); }
__device__ __forceinline__ float bfhi(unsigned w) { return __uint_as_float(w & 0xffff0000u); }
__device__ __forceinline__ float bf2f(bf16 u) { return __uint_as_float((unsigned)u << 16); }
__device__ __forceinline__ float silu_f(float g) { return g / (1.0f + __expf(-g)); }

template <int KIND> __device__ __forceinline__ int map_col(int d, float& sc) {
    sc = 1.0f;
    if (KIND == 0) { if (d < 512) sc = CQK; if (d < 1832) return d; if (d < 2048) return -1; return d - 216; }
    if (KIND == 2) { if (d < 512) sc = CQK; return d; }
    return d;
}
template <int KIND> __device__ __forceinline__ void p0_transpose_item(const float* W, int K, int Nsrc, int Ndst, bf16* WT, LAS float* scr, int item, int lane) {
    const int nblk = Ndst / 32, kb = item / nblk, nb = item % nblk, k0 = 64 * kb, n0 = 32 * nb;
    float sc; const int src = map_col<KIND>(n0 + (lane & 31), sc);
#pragma unroll 8
    for (int i = 0; i < 32; ++i) { const int kk = 2 * i + (lane >> 5); scr[kk * 33 + (lane & 31)] = (src >= 0) ? W[(size_t)(k0 + kk) * Nsrc + src] * sc : 0.0f; }
    LDS_WAIT(); asm volatile("" ::: "memory");
    const int c = lane & 7;
#pragma unroll
    for (int j = 0; j < 4; ++j) { const int n = (lane >> 3) + 8 * j; const LAS float* s = scr + (8 * c) * 33 + n;
        v4u o; o.x = pk2(s[0 * 33], s[1 * 33]); o.y = pk2(s[2 * 33], s[3 * 33]); o.z = pk2(s[4 * 33], s[5 * 33]); o.w = pk2(s[6 * 33], s[7 * 33]);
        *(GAS v4u*)(WT + (size_t)(n0 + n) * K + k0 + 8 * c) = o; }
    LDS_WAIT(); asm volatile("" ::: "memory");
}
struct Ptrs {
    const float* in[25]; float* out; unsigned char* ws;
};
__device__ __forceinline__ void p0_prologue(Frame& F, const Ptrs& P) {
    LAS float* scr = (LAS float*)(F.lds + RING_OFF + F.wave * 16384);
    const int gw = F.vcu * NWAVES + F.wave, NGW = F.G * NWAVES;
    bf16* W1T = (bf16*)(P.ws + WS_W1T); bf16* WO1T = (bf16*)(P.ws + WS_WO1T); bf16* W3T = (bf16*)(P.ws + WS_W3T); bf16* WO2T = (bf16*)(P.ws + WS_WO2T); bf16* W2T = (bf16*)(P.ws + WS_W2T);
    constexpr int I_1 = 16 * (N1 / 32), I_O = 16 * 32, I_3 = 16 * (N3 / 32);
    constexpr int NITEMS = I_1 + I_O + I_3 + I_O;
    for (int it = gw; it < NITEMS; it += NGW) {
        int r = it;
        if (r < I_1) { p0_transpose_item<0>(P.in[5], 1024, N1SRC, N1, W1T, scr, r, F.lane); continue; } r -= I_1;
        if (r < I_O) { p0_transpose_item<1>(P.in[16], 1024, 1024, 1024, WO1T, scr, r, F.lane); continue; } r -= I_O;
        if (r < I_3) { p0_transpose_item<2>(P.in[17], 1024, N3, N3, W3T, scr, r, F.lane); continue; } r -= I_3;
        p0_transpose_item<1>(P.in[23], 1024, 1024, 1024, WO2T, scr, r, F.lane);
    }
    {
        const float* gq = P.in[6]; const float* gkv = P.in[7]; const float* wuq = P.in[8]; const float* wqi = P.in[9]; const float* wuv = P.in[10];
        for (int e = (int)blockIdx.x * 512 + F.tid; e < N2 * 256; e += F.G * 512) {
            const int n = e >> 8, k = e & 255; float v = 0.0f;
            if (n < 1024) { if (k < 128) v = gq[k] * wuq[(size_t)(k * 8 + (n >> 7)) * 128 + (n & 127)] * CQL; }
            else if (n < 1280) { const int j = n - 1024; if (k < 128) v = gq[k] * wqi[(size_t)(k * 8 + (j >> 5)) * 32 + (j & 31)]; }
            else if (n < 1408) { const int j = n - 1280; if (k == 128 + j) v = gkv[j]; }
            else if (n < 1920) { const int j = n - 1408; if (k >= 128) v = gkv[k - 128] * wuv[(size_t)((j >> 6) * 128 + (k - 128)) * 64 + (j & 63)]; }
            W2T[e] = (bf16)f2bf(v);
        }
    }
    __syncthreads();
    {
        LAS float* sl = (LAS float*)(F.lds + RING_OFF);
        LAS float* red = sl + 8192;
        const float* c = P.in[1]; const float* adaw = P.in[2]; const float* adab = P.in[3]; float* mods = (float*)(P.ws + WS_MODS);
        bool loaded = false;
        for (int it = (int)blockIdx.x; it < 96; it += F.G) {
            if (!loaded) { for (int i = F.tid; i < 8192; i += 512) sl[i] = silu_f(c[i]); loaded = true; __syncthreads(); }
            const int l = it / 48, n0 = (it % 48) * 64, col = F.tid & 63, kg = F.tid >> 6;
            float acc[8];
#pragma unroll
            for (int b = 0; b < 8; ++b) acc[b] = 0.0f;
            const float* wp = adaw + ((size_t)l * 1024 + kg * 128) * 3072 + n0 + col;
            for (int k = 0; k < 128; ++k) { const float w = wp[(size_t)k * 3072];
#pragma unroll
                for (int b = 0; b < 8; ++b) acc[b] += sl[b * 1024 + kg * 128 + k] * w; }
#pragma unroll
            for (int b = 0; b < 8; ++b) red[(kg * 8 + b) * 64 + col] = acc[b];
            __syncthreads();
            { const int b = F.tid >> 6; float s = 0.0f;
#pragma unroll
              for (int g2 = 0; g2 < 8; ++g2) s += red[(g2 * 8 + b) * 64 + col];
              mods[((size_t)l * 8 + b) * 3072 + n0 + col] = s + adab[l * 3072 + n0 + col]; }
            __syncthreads();
        }
    }
}

__device__ __forceinline__ void xn_phase(Frame& F, const float* xin, const float* g, const float* mods_l, bf16* XN) {
    const int gw = F.vcu * NWAVES + F.wave, NGW = F.G * NWAVES;
    for (int m = gw; m < M; m += NGW) {
        const int b = m >> 11;
        const GAS f32x4* xr = (const GAS f32x4*)(xin + (size_t)m * DM) + F.lane;
        f32x4 v[4]; float s = 0.f;
#pragma unroll
        for (int j = 0; j < 4; ++j) { v[j] = xr[64 * j]; s += (v[j].x * v[j].x + v[j].y * v[j].y) + (v[j].z * v[j].z + v[j].w * v[j].w); }
        const float rstd = 1.0f / sqrtf(wave_sum(s) * (1.0f / DM) + EPS);
        GAS unsigned long long* o8 = (GAS unsigned long long*)(XN + (size_t)m * DM) + F.lane;
#pragma unroll
        for (int j = 0; j < 4; ++j) { const int col = 4 * F.lane + 256 * j;
            const f32x4 gv = *(const f32x4*)(g + col), sc = *(const f32x4*)(mods_l + (size_t)b * 3072 + 1024 + col), sh = *(const f32x4*)(mods_l + (size_t)b * 3072 + col);
            const f32x4 h = v[j] * rstd * gv * (sc + 1.0f) + sh;
            o8[64 * j] = (unsigned long long)pk2(h.x, h.y) | ((unsigned long long)pk2(h.z, h.w) << 32); }
    }
}
__device__ __forceinline__ void final_norm_phase(Frame& F, float* x, const float* g) {
    const int gw = F.vcu * NWAVES + F.wave, NGW = F.G * NWAVES;
    for (int m = gw; m < M; m += NGW) {
        GAS f32x4* xr = (GAS f32x4*)(x + (size_t)m * DM) + F.lane;
        f32x4 v[4]; float s = 0.f;
#pragma unroll
        for (int j = 0; j < 4; ++j) { v[j] = xr[64 * j]; s += (v[j].x * v[j].x + v[j].y * v[j].y) + (v[j].z * v[j].z + v[j].w * v[j].w); }
        const float rstd = 1.0f / sqrtf(wave_sum(s) * (1.0f / DM) + EPS);
#pragma unroll
        for (int j = 0; j < 4; ++j) { const f32x4 gv = *(const f32x4*)(g + 4 * F.lane + 256 * j); xr[64 * j] = v[j] * rstd * gv; }
    }
}

__device__ __forceinline__ unsigned long long lowest_n_bits(unsigned long long e, int n) {
    unsigned long long r = 0ull;
    while (n > 0 && e) { const unsigned long long b = e & (0ull - e); r |= b; e ^= b; --n; }
    return r;
}
__device__ __forceinline__ unsigned long long topk_select(const unsigned (&keyv)[32], int lane) {
    unsigned T = 0u;
    for (int bit = 31; bit >= 0; --bit) {
        const unsigned cand = T | (1u << bit); int cnt = 0;
#pragma unroll
        for (int i = 0; i < 32; ++i) cnt += __popcll(__ballot(keyv[i] >= cand));
        if (cnt >= TOPK) T = cand;
    }
    int cgt = 0;
#pragma unroll
    for (int i = 0; i < 32; ++i) cgt += __popcll(__ballot(keyv[i] > T));
    int need = TOPK - cgt;
    unsigned long long mine = 0ull;
#pragma unroll
    for (int i = 0; i < 32; ++i) {
        const unsigned long long g = __ballot(keyv[i] > T), e = __ballot(keyv[i] == T);
        const int ne = __popcll(e);
        unsigned long long take;
        if (ne <= need) { take = e; need -= ne; } else { take = lowest_n_bits(e, need); need = 0; }
        const unsigned long long word = g | take;
        mine = (lane == i) ? word : mine;
    }
    return mine;
}
__device__ __forceinline__ unsigned sort_key(float v) { const unsigned u = __float_as_uint(v); return (u & 0x80000000u) ? ~u : (u | 0x80000000u); }

__device__ __forceinline__ void indexer_naive(Frame& F, const bf16* Y1, const bf16* QL, unsigned long long* MASK) {
    const int gw = F.vcu * NWAVES + F.wave, NGW = F.G * NWAVES, lane = F.lane;
    LAS float* qs = (LAS float*)(F.lds + RING_OFF + F.wave * 9216);
    LAS float* sc = qs + 256;
    for (int row = gw; row < M; row += NGW) {
        const int b = row >> 11, q = row & 2047;
        { const uint2 w2 = *(const uint2*)(QL + (size_t)row * N2 + QL_QIDX + 4 * lane);
          qs[4 * lane + 0] = bflo(w2.x); qs[4 * lane + 1] = bfhi(w2.x); qs[4 * lane + 2] = bflo(w2.y); qs[4 * lane + 3] = bfhi(w2.y); }
        float w[8];
        { const uint4 wv = *(const uint4*)(Y1 + (size_t)row * N1 + Y1_WIDX);
          w[0] = bflo(wv.x); w[1] = bfhi(wv.x); w[2] = bflo(wv.y); w[3] = bfhi(wv.y); w[4] = bflo(wv.z); w[5] = bfhi(wv.z); w[6] = bflo(wv.w); w[7] = bfhi(wv.w); }
        LDS_WAIT(); asm volatile("" ::: "memory");
        const int nw = (q >> 6) + 1;
        unsigned long long mine = 0ull;
        if (q + 1 <= TOPK) {
#pragma unroll
            for (int i = 0; i < 32; ++i) { const unsigned long long word = __ballot(64 * i + lane <= q); mine = (lane == i) ? word : mine; }
        } else {
            for (int i = 0; i < nw; ++i) {
                const int key = 64 * i + lane; float s = -INFINITY;
                if (key <= q) {
                    const uint4* kp = (const uint4*)(Y1 + (size_t)(b * SEQ + key) * N1 + Y1_KIDX);
                    float k[32];
#pragma unroll
                    for (int j = 0; j < 4; ++j) { const uint4 kv = kp[j];
                        k[8 * j + 0] = bflo(kv.x); k[8 * j + 1] = bfhi(kv.x); k[8 * j + 2] = bflo(kv.y); k[8 * j + 3] = bfhi(kv.y);
                        k[8 * j + 4] = bflo(kv.z); k[8 * j + 5] = bfhi(kv.z); k[8 * j + 6] = bflo(kv.w); k[8 * j + 7] = bfhi(kv.w); }
                    float acc = 0.0f;
#pragma unroll
                    for (int h = 0; h < 8; ++h) { float d = 0.0f;
#pragma unroll
                        for (int t = 0; t < 32; ++t) d += k[t] * qs[h * 32 + t];
                        acc += w[h] * fmaxf(d, 0.0f); }
                    s = acc + 0.0f;
                }
                sc[key] = s;
            }
            LDS_WAIT(); asm volatile("" ::: "memory");
            unsigned keyv[32];
#pragma unroll
            for (int i = 0; i < 32; ++i) { const float v = (i < nw) ? sc[64 * i + lane] : -INFINITY; keyv[i] = sort_key(v); }
            mine = topk_select(keyv, lane);
        }
        if (lane < 32) MASK[(size_t)row * 32 + lane] = mine;
        LDS_WAIT(); asm volatile("" ::: "memory");
    }
}

__device__ __forceinline__ void diffattn_naive(Frame& F, const Ptrs& P, const bf16* Y1, bf16* YC) {
    const int gw = F.vcu * NWAVES + F.wave, NGW = F.G * NWAVES, lane = F.lane, l5 = lane & 31;
    const float lam = __expf(wave_sum(P.in[11][lane] * P.in[12][lane])) - __expf(wave_sum(P.in[13][lane] * P.in[14][lane])) + LAM_INIT;
    const float* subg = P.in[15];
    for (int task = gw; task < M * 4; task += NGW) {
        const int row = task >> 2, h = task & 3, b = row >> 11, q = row & 2047;
        const unsigned qv = *(const unsigned*)(Y1 + (size_t)row * N1 + Y1_QA + 128 * h + 2 * lane);
        const float q0 = bflo(qv), q1 = bfhi(qv);
        const float slope2 = exp2f(-2.0f * (float)(h + 1)) * LOG2E;
        float m = -1e30f, l = 0.0f, o[4] = {0.f, 0.f, 0.f, 0.f};
        const bf16* Kb = Y1 + (size_t)(b * SEQ) * N1 + Y1_KA + 128 * h + 2 * lane;
        const bf16* Vb = Y1 + (size_t)(b * SEQ) * N1 + Y1_VA + 128 * h + 4 * l5;
        for (int k0 = 0; k0 <= q; k0 += 4) {
            unsigned kk[4]; uint2 vv[4];
#pragma unroll
            for (int j = 0; j < 4; ++j) { const int k = min(k0 + j, q); kk[j] = *(const unsigned*)(Kb + (size_t)k * N1); vv[j] = *(const uint2*)(Vb + (size_t)k * N1); }
#pragma unroll
            for (int j = 0; j < 4; ++j) {
                const int k = k0 + j;
                float part = q0 * bflo(kk[j]) + q1 * bfhi(kk[j]);
                part += __shfl_xor(part, 1); part += __shfl_xor(part, 2); part += __shfl_xor(part, 4); part += __shfl_xor(part, 8); part += __shfl_xor(part, 16);
                if (k <= q) {
                    const float s = part - slope2 * (float)(q - k);
                    const float mn = fmaxf(m, s), alpha = exp2f(m - mn), p = exp2f(s - mn);
                    l = l * alpha + p;
                    o[0] = o[0] * alpha + p * bflo(vv[j].x); o[1] = o[1] * alpha + p * bfhi(vv[j].x); o[2] = o[2] * alpha + p * bflo(vv[j].y); o[3] = o[3] * alpha + p * bfhi(vv[j].y);
                    m = mn;
                }
            }
        }
        const float il = 1.0f / l;
        float d[4]; float ss = 0.0f;
#pragma unroll
        for (int i = 0; i < 4; ++i) { const float mine = o[i] * il, other = __shfl_xor(mine, 32); d[i] = mine - lam * other; ss += d[i] * d[i]; }
        ss += __shfl_xor(ss, 1); ss += __shfl_xor(ss, 2); ss += __shfl_xor(ss, 4); ss += __shfl_xor(ss, 8); ss += __shfl_xor(ss, 16);
        const float rs = 1.0f / sqrtf(ss * (1.0f / 128.0f) + EPS) * (1.0f - LAM_INIT);
        if (lane < 32) {
            const uint2 gv = *(const uint2*)(Y1 + (size_t)row * N1 + Y1_GATE + 128 * h + 4 * l5);
            const float g0 = bflo(gv.x), g1 = bfhi(gv.x), g2 = bflo(gv.y), g3 = bfhi(gv.y);
            const float y0 = d[0] * rs * subg[4 * l5 + 0] * silu_f(g0), y1 = d[1] * rs * subg[4 * l5 + 1] * silu_f(g1), y2 = d[2] * rs * subg[4 * l5 + 2] * silu_f(g2), y3 = d[3] * rs * subg[4 * l5 + 3] * silu_f(g3);
            *(uint2*)(YC + (size_t)row * DM + 128 * h + 4 * l5) = make_uint2(pk2(y0, y1), pk2(y2, y3));
        }
    }
}

__device__ __forceinline__ void dsa_naive(Frame& F, const bf16* Y1, const bf16* QL, const unsigned long long* MASK, bf16* YC) {
    const int gw = F.vcu * NWAVES + F.wave, NGW = F.G * NWAVES, lane = F.lane, h = lane >> 3, j = lane & 7;
    const float slope2 = exp2f(-(float)(h + 1)) * LOG2E;
    for (int row = gw; row < M; row += NGW) {
        const int b = row >> 11, q = row & 2047;
        float qf[16];
        { const uint4* qp = (const uint4*)(QL + (size_t)row * N2 + 128 * h + 16 * j);
#pragma unroll
          for (int t = 0; t < 2; ++t) { const uint4 v = qp[t]; qf[8 * t + 0] = bflo(v.x); qf[8 * t + 1] = bfhi(v.x); qf[8 * t + 2] = bflo(v.y); qf[8 * t + 3] = bfhi(v.y); qf[8 * t + 4] = bflo(v.z); qf[8 * t + 5] = bfhi(v.z); qf[8 * t + 6] = bflo(v.w); qf[8 * t + 7] = bfhi(v.w); } }
        float m = -1e30f, l = 0.0f, o[8];
#pragma unroll
        for (int i = 0; i < 8; ++i) o[i] = 0.0f;
        const int nw = (q >> 6) + 1;
        for (int t = 0; t < nw; ++t) {
            const unsigned long long wraw = MASK[(size_t)row * 32 + t];
            unsigned long long w = ((unsigned long long)(unsigned)__builtin_amdgcn_readfirstlane((int)(wraw >> 32)) << 32) | (unsigned)__builtin_amdgcn_readfirstlane((int)(unsigned)wraw);
            while (w) {
                const int bit = __builtin_ctzll(w); w &= w - 1ull;
                const int k = 64 * t + bit; const bf16* kr = QL + (size_t)(b * SEQ + k) * N2;
                const uint4 ka = *(const uint4*)(kr + QL_KV + 16 * j), kb = *(const uint4*)(kr + QL_KV + 16 * j + 8);
                const uint4 vp = *(const uint4*)(kr + QL_VP + 64 * h + 8 * j);
                float part = qf[0] * bflo(ka.x) + qf[1] * bfhi(ka.x) + qf[2] * bflo(ka.y) + qf[3] * bfhi(ka.y) + qf[4] * bflo(ka.z) + qf[5] * bfhi(ka.z) + qf[6] * bflo(ka.w) + qf[7] * bfhi(ka.w)
                           + qf[8] * bflo(kb.x) + qf[9] * bfhi(kb.x) + qf[10] * bflo(kb.y) + qf[11] * bfhi(kb.y) + qf[12] * bflo(kb.z) + qf[13] * bfhi(kb.z) + qf[14] * bflo(kb.w) + qf[15] * bfhi(kb.w);
                part += __shfl_xor(part, 1); part += __shfl_xor(part, 2); part += __shfl_xor(part, 4);
                const float s = part - slope2 * (float)(q - k);
                const float mn = fmaxf(m, s), alpha = exp2f(m - mn), p = exp2f(s - mn);
                l = l * alpha + p; m = mn;
                o[0] = o[0] * alpha + p * bflo(vp.x); o[1] = o[1] * alpha + p * bfhi(vp.x); o[2] = o[2] * alpha + p * bflo(vp.y); o[3] = o[3] * alpha + p * bfhi(vp.y);
                o[4] = o[4] * alpha + p * bflo(vp.z); o[5] = o[5] * alpha + p * bfhi(vp.z); o[6] = o[6] * alpha + p * bflo(vp.w); o[7] = o[7] * alpha + p * bfhi(vp.w);
            }
        }
        const float il = 1.0f / l;
        const uint4 gv = *(const uint4*)(Y1 + (size_t)row * N1 + Y1_GATE + 512 + 64 * h + 8 * j);
        const float g[8] = {bflo(gv.x), bfhi(gv.x), bflo(gv.y), bfhi(gv.y), bflo(gv.z), bfhi(gv.z), bflo(gv.w), bfhi(gv.w)};
        float y[8];
#pragma unroll
        for (int i = 0; i < 8; ++i) y[i] = o[i] * il * silu_f(g[i]);
        *(uint4*)(YC + (size_t)row * DM + 512 + 64 * h + 8 * j) = make_uint4(pk2(y[0], y[1]), pk2(y[2], y[3]), pk2(y[4], y[5]), pk2(y[6], y[7]));
    }
}

__device__ __forceinline__ void swa_naive(Frame& F, const Ptrs& P, const bf16* Y2, bf16* YC) {
    const int gw = F.vcu * NWAVES + F.wave, NGW = F.G * NWAVES, lane = F.lane;
    LAS float* qs = (LAS float*)(F.lds + RING_OFF + F.wave * 1024);
    const float* sinks = P.in[18];
    for (int task = gw; task < M * 8; task += NGW) {
        const int row = task >> 3, head = task & 7, g = head >> 2, b = row >> 11, q = row & 2047;
        qs[lane] = bf2f(Y2[(size_t)row * N3 + 64 * head + lane]);
        LDS_WAIT(); asm volatile("" ::: "memory");
        const float slope2 = exp2f(-(float)(head + 1)) * LOG2E, sink2 = sinks[head] * LOG2E;
        float s2[2];
#pragma unroll
        for (int ds = 0; ds < 2; ++ds) {
            const int dist = lane + 64 * ds, k = q - dist; float s = -INFINITY;
            if (k >= 0) {
                const uint4* kp = (const uint4*)(Y2 + (size_t)(b * SEQ + k) * N3 + Y2_KC + 64 * g);
                float dot = 0.0f;
#pragma unroll
                for (int t = 0; t < 8; ++t) { const uint4 kv = kp[t];
                    dot += qs[8 * t + 0] * bflo(kv.x) + qs[8 * t + 1] * bfhi(kv.x) + qs[8 * t + 2] * bflo(kv.y) + qs[8 * t + 3] * bfhi(kv.y)
                         + qs[8 * t + 4] * bflo(kv.z) + qs[8 * t + 5] * bfhi(kv.z) + qs[8 * t + 6] * bflo(kv.w) + qs[8 * t + 7] * bfhi(kv.w); }
                s = dot - slope2 * (float)dist;
            }
            s2[ds] = s;
        }
        const float m = fmaxf(wave_max(fmaxf(s2[0], s2[1])), sink2);
        const float p0 = exp2f(s2[0] - m), p1 = exp2f(s2[1] - m);
        const float denom = wave_sum(p0 + p1) + exp2f(sink2 - m);
        float acc = 0.0f;
        const int nd = min(127, q);
        const bf16* vb = Y2 + (size_t)(b * SEQ) * N3 + Y2_VC + 64 * g + lane;
        for (int dist = 0; dist <= nd; ++dist) {
            const float p = (dist < 64) ? __shfl(p0, dist) : __shfl(p1, dist - 64);
            acc += p * bf2f(vb[(size_t)(q - dist) * N3]);
        }
        const float gt = bf2f(Y2[(size_t)row * N3 + Y2_GATE + 64 * head + lane]);
        YC[(size_t)row * DM + 64 * head + lane] = (bf16)f2bf(acc / denom * silu_f(gt));
        LDS_WAIT(); asm volatile("" ::: "memory");
    }
}

__device__ __forceinline__ void conv_phase(Frame& F, const Ptrs& P, const bf16* Y2, bf16* YC) {
    LAS float* CO = (LAS float*)(F.lds + RING_OFF);
    const float* dww = P.in[19]; const float* dwb = P.in[20]; const float* lng = P.in[21]; const float* lnb = P.in[22];
    const int c = F.tid;
    float wt[31];
#pragma unroll
    for (int j = 0; j < 31; ++j) wt[j] = dww[j * 512 + c];
    const float bias = dwb[c];
    for (int u = F.vcu; u < BATCH * 64; u += F.G) {
        const int b = u >> 6, t0 = (u & 63) * 32;
        float h[62];
#pragma unroll
        for (int r = 0; r < 62; ++r) { const int pos = t0 - 30 + r; float v = 0.0f;
            if (pos >= 0) { const bf16* rp = Y2 + (size_t)(b * SEQ + pos) * N3; const float val = bf2f(rp[Y2_DVAL + c]), gt = bf2f(rp[Y2_DGATE + c]); v = val / (1.0f + __expf(-gt)); }
            h[r] = v; }
#pragma unroll
        for (int t = 0; t < 32; ++t) { float a = bias;
#pragma unroll
            for (int j = 0; j < 31; ++j) a += wt[j] * h[t + j];
            CO[t * 512 + c] = a; }
        __syncthreads();
#pragma unroll
        for (int tt = 0; tt < 4; ++tt) { const int t = F.wave * 4 + tt, row = b * SEQ + t0 + t;
            float v[8]; float s = 0.0f;
#pragma unroll
            for (int i = 0; i < 8; ++i) { v[i] = CO[t * 512 + F.lane + 64 * i]; s += v[i]; }
            const float mu = wave_sum(s) * (1.0f / 512.0f); float s2 = 0.0f;
#pragma unroll
            for (int i = 0; i < 8; ++i) { v[i] -= mu; s2 += v[i] * v[i]; }
            const float rstd = 1.0f / sqrtf(wave_sum(s2) * (1.0f / 512.0f) + EPS);
#pragma unroll
            for (int i = 0; i < 8; ++i) { const int ch = F.lane + 64 * i; const float y = v[i] * rstd * lng[ch] + lnb[ch];
                const float gt = bf2f(Y2[(size_t)row * N3 + Y2_GATE + 512 + ch]);
                YC[(size_t)row * DM + 512 + ch] = (bf16)f2bf(silu_f(y) * silu_f(gt)); } }
        __syncthreads();
    }
}

namespace fa {
typedef short bf16x8 __attribute__((ext_vector_type(8)));
typedef short s16x4 __attribute__((ext_vector_type(4)));
typedef float f32x16 __attribute__((ext_vector_type(16)));
typedef float f32x4 __attribute__((ext_vector_type(4)));
constexpr int BUF_BYTES = 32768, V_OFF = 16384, SCR_OFF = 65536;
constexpr float THR = 6.0f;
__device__ __forceinline__ unsigned offb(unsigned row, unsigned ch) { return 256u * row + 16u * (ch ^ (((row & 3u) << 2) | ((row >> 2) & 3u))); }
__device__ __forceinline__ constexpr int cr(int r) { return (r & 3) + 8 * (r >> 2); }
__device__ __forceinline__ unsigned cvtpk(float lo, float hi) { typedef float f2 __attribute__((ext_vector_type(2))); typedef __bf16 b2 __attribute__((ext_vector_type(2))); f2 v = {lo, hi}; b2 b = __builtin_convertvector(v, b2); return __builtin_bit_cast(unsigned, b); }
typedef short v4i16_t __attribute__((ext_vector_type(4)));
__device__ __forceinline__ s16x4 vtr(const LAS unsigned char* p) { return __builtin_bit_cast(s16x4, __builtin_amdgcn_ds_read_tr16_b64_v4i16((LAS v4i16_t*)p)); }

struct Epi {
    const bf16* gate; int gpitch;
    bf16* out;
    float lam; const float* subg;
};

template <int MODE> __device__ __forceinline__ void attn_unit(LAS unsigned char* lds, const bf16* Qw, int qp, const bf16* Kt, const bf16* Vt, int kvp,
                                                              int kc0, int vb0, int qw, int t_lo, int t_hi, float slope2, const unsigned long long* maskw, float sink2, const Epi& E) {
    constexpr int DQK = (MODE == 1) ? 128 : 64, DV = (MODE == 0) ? 128 : 64, NS = DQK / 16, NB = DV / 32;
    const int tid = threadIdx.x, lane = tid & 63, r32 = lane & 31, hi = lane >> 5, wid = __builtin_amdgcn_readfirstlane(tid >> 6);
    const int q = qw + r32;
    LAS float* scr = (LAS float*)(lds + SCR_OFF + wid * 128);
    const int srow0 = tid >> 4, sch = tid & 15;
    const unsigned sw0 = offb(srow0, sch), sw1 = offb(srow0 + 32, sch);
    const bf16* gk = Kt + (size_t)srow0 * kvp + 8 * sch; const bf16* gv = Vt + (size_t)srow0 * kvp + 8 * sch;
    v4u sk0, sk1, sv0, sv1;
#define FA_LOAD(t) do { const size_t o_ = (size_t)(t) * 64 * kvp; sk0 = *(const v4u*)(gk + o_); sk1 = *(const v4u*)(gk + o_ + (size_t)32 * kvp); sv0 = *(const v4u*)(gv + o_); sv1 = *(const v4u*)(gv + o_ + (size_t)32 * kvp); } while (0)
#define FA_WRITE(b) do { LAS unsigned char* p_ = lds + (b) * BUF_BYTES; *(LAS v4u*)(p_ + sw0) = sk0; *(LAS v4u*)(p_ + sw1) = sk1; *(LAS v4u*)(p_ + V_OFF + sw0) = sv0; *(LAS v4u*)(p_ + V_OFF + sw1) = sv1; } while (0)
    const unsigned xl = ((((unsigned)r32 & 3u) << 2) | (((unsigned)r32 >> 2) & 3u)) ^ (unsigned)hi;
    const unsigned krow = 256u * (unsigned)r32;
    const unsigned blk = (lane >> 4) & 1, qq = (lane & 15) >> 2, pp = lane & 3;
    unsigned VA[2][NB];
#pragma unroll
    for (int t = 0; t < 2; ++t)
#pragma unroll
        for (int c = 0; c < NB; ++c) VA[t][c] = V_OFF + 256u * (4u * hi + qq) + 8u * (pp & 1u) + 16u * ((((2u * blk + (pp >> 1)) ^ (unsigned)hi)) ^ (2u * t)) + 64u * ((((unsigned)(vb0 + c)) ^ qq) & 3u) + 2048u * t;
    bf16x8 qf[NS];
#pragma unroll
    for (int s = 0; s < NS; ++s) qf[s] = *(const bf16x8*)(Qw + (size_t)r32 * qp + 16 * s + 8 * hi);
    f32x16 o[NB];
#pragma unroll
    for (int c = 0; c < NB; ++c)
#pragma unroll
        for (int r = 0; r < 16; ++r) o[c][r] = 0.0f;
    float m = -1e30f, l = 0.0f;
    unsigned long long mw_next = 0ull;
    if (MODE == 1) mw_next = maskw[(size_t)r32 * 32 + t_lo];

    FA_LOAD(t_lo); FA_WRITE(0); __syncthreads();
    for (int t = t_lo; t < t_hi; ++t) {
        const int cur = (t - t_lo) & 1;
        const bool more = (t + 1 < t_hi);
        if (more) FA_LOAD(t + 1);
        unsigned long long mw = mw_next;
        if (MODE == 1 && more) mw_next = maskw[(size_t)r32 * 32 + t + 1];
        bool active = (64 * t <= qw + 31);
        if (MODE == 2) active = active && (64 * t + 63 >= qw - 127);
        if (active) {
            const LAS unsigned char* kb = lds + cur * BUF_BYTES;
            f32x16 p0, p1;
            { const float d0 = slope2 * (float)(64 * t - q + 4 * hi);
#pragma unroll
              for (int r = 0; r < 16; ++r) { p0[r] = __builtin_fmaf(slope2, (float)cr(r), d0); p1[r] = __builtin_fmaf(slope2, (float)(cr(r) + 32), d0); } }
#pragma unroll
            for (int s = 0; s < NS; ++s) {
                const unsigned ko = krow + 16u * (((unsigned)(kc0 + 2 * s)) ^ xl);
                const bf16x8 a0 = *(const LAS bf16x8*)(kb + ko), a1 = *(const LAS bf16x8*)(kb + ko + 8192u);
                p0 = __builtin_amdgcn_mfma_f32_32x32x16_bf16(a0, qf[s], p0, 0, 0, 0);
                p1 = __builtin_amdgcn_mfma_f32_32x32x16_bf16(a1, qf[s], p1, 0, 0, 0);
            }
            if (MODE == 0) {
                if (64 * t + 63 > qw) { const int qd = q - 64 * t - 4 * hi;
#pragma unroll
                    for (int r = 0; r < 16; ++r) { if (cr(r) > qd) p0[r] = -INFINITY; if (cr(r) + 32 > qd) p1[r] = -INFINITY; } }
            } else if (MODE == 2) {
                const int qd = q - 64 * t - 4 * hi;
#pragma unroll
                for (int r = 0; r < 16; ++r) { const int d0_ = qd - cr(r), d1_ = d0_ - 32; if (d0_ < 0 || d0_ > 127) p0[r] = -INFINITY; if (d1_ < 0 || d1_ > 127) p1[r] = -INFINITY; }
            } else {
                const int wl = (int)((unsigned)mw >> (4 * hi)), wh = (int)((unsigned)(mw >> 32) >> (4 * hi));
#pragma unroll
                for (int r = 0; r < 16; ++r) {
                    const int m0 = __builtin_amdgcn_sbfe(wl, cr(r), 1), m1 = __builtin_amdgcn_sbfe(wh, cr(r), 1);
                    p0[r] = __int_as_float((__float_as_int(p0[r]) & m0) | (~m0 & (int)0xff800000));
                    p1[r] = __int_as_float((__float_as_int(p1[r]) & m1) | (~m1 & (int)0xff800000));
                }
            }
            float rm = fmaxf(p0[0], p1[0]);
#pragma unroll
            for (int r = 1; r < 16; ++r) rm = fmaxf(rm, fmaxf(p0[r], p1[r]));
            { auto rr = __builtin_amdgcn_permlane32_swap(__float_as_uint(rm), __float_as_uint(rm), false, false); rm = fmaxf(__uint_as_float(rr[0]), __uint_as_float(rr[1])); }
            if (__any(rm > m + THR)) {
                const float mn = fmaxf(m, rm), f = __builtin_amdgcn_exp2f(m - mn); m = mn; l *= f;
                if (hi == 0) scr[r32] = f;
                asm volatile("s_waitcnt lgkmcnt(0)" ::: "memory");
#pragma unroll
                for (int g = 0; g < 4; ++g) { const f32x4 fv = *(const LAS f32x4*)(scr + 8 * g + 4 * hi);
#pragma unroll
                    for (int c = 0; c < NB; ++c) { o[c][4 * g + 0] *= fv[0]; o[c][4 * g + 1] *= fv[1]; o[c][4 * g + 2] *= fv[2]; o[c][4 * g + 3] *= fv[3]; } }
            }
            float ls = 0.0f;
#pragma unroll
            for (int r = 0; r < 16; ++r) { p0[r] = __builtin_amdgcn_exp2f(p0[r] - m); p1[r] = __builtin_amdgcn_exp2f(p1[r] - m); ls += p0[r] + p1[r]; }
            l += ls;
            bf16x8 pa[4];
#pragma unroll
            for (int s = 0; s < 2; ++s) {
                const unsigned a0 = cvtpk(p0[8 * s + 0], p0[8 * s + 1]), a1 = cvtpk(p0[8 * s + 2], p0[8 * s + 3]), a2 = cvtpk(p0[8 * s + 4], p0[8 * s + 5]), a3 = cvtpk(p0[8 * s + 6], p0[8 * s + 7]);
                const unsigned b0 = cvtpk(p1[8 * s + 0], p1[8 * s + 1]), b1 = cvtpk(p1[8 * s + 2], p1[8 * s + 3]), b2 = cvtpk(p1[8 * s + 4], p1[8 * s + 5]), b3 = cvtpk(p1[8 * s + 6], p1[8 * s + 7]);
                pa[s] = __builtin_bit_cast(bf16x8, (v4u){a0, a1, a2, a3}); pa[2 + s] = __builtin_bit_cast(bf16x8, (v4u){b0, b1, b2, b3});
            }
#pragma unroll
            for (int c = 0; c < NB; ++c)
#pragma unroll
                for (int ks = 0; ks < 4; ++ks) {
                    const s16x4 v0 = vtr(kb + VA[0][c] + 4096u * ks), v1 = vtr(kb + VA[1][c] + 4096u * ks);
                    const bf16x8 vf = (bf16x8){v0[0], v0[1], v0[2], v0[3], v1[0], v1[1], v1[2], v1[3]};
                    o[c] = __builtin_amdgcn_mfma_f32_32x32x16_bf16(pa[ks], vf, o[c], 0, 0, 0);
                }
        }
        if (more) FA_WRITE(cur ^ 1);
        __syncthreads();
    }
#undef FA_LOAD
#undef FA_WRITE
    { auto rr = __builtin_amdgcn_permlane32_swap(__float_as_uint(l), __float_as_uint(l), false, false); l = __uint_as_float(rr[0]) + __uint_as_float(rr[1]); }
    if (MODE == 2) l += exp2f(sink2 - m);
    float il = 1.0f / l;
    if (MODE == 0 && wid >= 4) il *= E.lam;
    if (hi == 0) scr[r32] = il;
    asm volatile("s_waitcnt lgkmcnt(0)" ::: "memory");
    float ilr[16];
#pragma unroll
    for (int g = 0; g < 4; ++g) { const f32x4 fv = *(const LAS f32x4*)(scr + 8 * g + 4 * hi); ilr[4 * g + 0] = fv[0]; ilr[4 * g + 1] = fv[1]; ilr[4 * g + 2] = fv[2]; ilr[4 * g + 3] = fv[3]; }
    if (MODE == 0) {
        LAS float* X = (LAS float*)(lds + (wid & 3) * 16384);
        if (wid >= 4) {
#pragma unroll
            for (int c = 0; c < NB; ++c)
#pragma unroll
                for (int r = 0; r < 16; ++r) X[(cr(r) + 4 * hi) * 128 + 32 * c + r32] = o[c][r] * ilr[r];
        }
        __syncthreads();
        if (wid < 4) {
#pragma unroll
            for (int c = 0; c < NB; ++c)
#pragma unroll
                for (int r = 0; r < 16; ++r) { LAS float* xp = X + (cr(r) + 4 * hi) * 128 + 32 * c + r32; *xp = o[c][r] * ilr[r] - *xp; }
            asm volatile("s_waitcnt lgkmcnt(0)" ::: "memory");
#pragma unroll
            for (int i = 0; i < 8; ++i) { const int id = lane + 64 * i, row = id >> 4, ch = id & 15;
                const f32x4 v0 = *(const LAS f32x4*)(X + row * 128 + 8 * ch), v1 = *(const LAS f32x4*)(X + row * 128 + 8 * ch + 4);
                float ss = (v0[0] * v0[0] + v0[1] * v0[1]) + (v0[2] * v0[2] + v0[3] * v0[3]) + (v1[0] * v1[0] + v1[1] * v1[1]) + (v1[2] * v1[2] + v1[3] * v1[3]);
                ss += __shfl_xor(ss, 1); ss += __shfl_xor(ss, 2); ss += __shfl_xor(ss, 4); ss += __shfl_xor(ss, 8);
                const float rs = 1.0f / sqrtf(ss * (1.0f / 128.0f) + EPS) * (1.0f - LAM_INIT);
                const uint4 gv = *(const uint4*)(E.gate + (size_t)row * E.gpitch + 8 * ch);
                const f32x4 s0 = *(const f32x4*)(E.subg + 8 * ch), s1 = *(const f32x4*)(E.subg + 8 * ch + 4);
                const float y0 = v0[0] * rs * s0[0] * silu_f(bflo(gv.x)), y1 = v0[1] * rs * s0[1] * silu_f(bfhi(gv.x)), y2 = v0[2] * rs * s0[2] * silu_f(bflo(gv.y)), y3 = v0[3] * rs * s0[3] * silu_f(bfhi(gv.y));
                const float y4 = v1[0] * rs * s1[0] * silu_f(bflo(gv.z)), y5 = v1[1] * rs * s1[1] * silu_f(bfhi(gv.z)), y6 = v1[2] * rs * s1[2] * silu_f(bflo(gv.w)), y7 = v1[3] * rs * s1[3] * silu_f(bfhi(gv.w));
                *(uint4*)(E.out + (size_t)row * 1024 + 8 * ch) = make_uint4(cvtpk(y0, y1), cvtpk(y2, y3), cvtpk(y4, y5), cvtpk(y6, y7)); }
        }
        __syncthreads();
    } else {
        LAS float* X = (LAS float*)(lds + wid * 8192);
#pragma unroll
        for (int c = 0; c < NB; ++c)
#pragma unroll
            for (int r = 0; r < 16; ++r) X[(cr(r) + 4 * hi) * 64 + 32 * c + r32] = o[c][r] * ilr[r];
        asm volatile("s_waitcnt lgkmcnt(0)" ::: "memory");
#pragma unroll
        for (int i = 0; i < 4; ++i) { const int id = lane + 64 * i, row = id >> 3, ch = id & 7;
            const f32x4 v0 = *(const LAS f32x4*)(X + row * 64 + 8 * ch), v1 = *(const LAS f32x4*)(X + row * 64 + 8 * ch + 4);
            const uint4 gv = *(const uint4*)(E.gate + (size_t)row * E.gpitch + 8 * ch);
            const float y0 = v0[0] * silu_f(bflo(gv.x)), y1 = v0[1] * silu_f(bfhi(gv.x)), y2 = v0[2] * silu_f(bflo(gv.y)), y3 = v0[3] * silu_f(bfhi(gv.y));
            const float y4 = v1[0] * silu_f(bflo(gv.z)), y5 = v1[1] * silu_f(bfhi(gv.z)), y6 = v1[2] * silu_f(bflo(gv.w)), y7 = v1[3] * silu_f(bfhi(gv.w));
            *(uint4*)(E.out + (size_t)row * 1024 + 8 * ch) = make_uint4(cvtpk(y0, y1), cvtpk(y2, y3), cvtpk(y4, y5), cvtpk(y6, y7)); }
        __syncthreads();
    }
}
}

__device__ __forceinline__ void attn_phase_a(Frame& F, const Ptrs& P, const bf16* Y1, bf16* YC) {
    const int w = F.wave, qg = w & 3, role = w >> 2;
    const float lam = __expf(wave_sum(P.in[11][F.lane] * P.in[12][F.lane])) - __expf(wave_sum(P.in[13][F.lane] * P.in[14][F.lane])) + LAM_INIT;
    for (int v = F.vcu; v < 256; v += F.G) {
        const int bh = v >> 3, s = v & 7, b = bh >> 2, h = bh & 3; const size_t r0 = (size_t)b * SEQ;
        for (int i = 0; i < 2; ++i) {
            const int qb = i == 0 ? s : 15 - s, q0 = 128 * qb, qw = q0 + 32 * qg;
            fa::Epi E; E.gate = Y1 + (r0 + qw) * N1 + Y1_GATE + 128 * h; E.gpitch = N1; E.out = YC + (r0 + qw) * DM + 128 * h; E.lam = lam; E.subg = P.in[15];
            fa::attn_unit<0>(F.lds + RING_OFF, Y1 + (r0 + qw) * N1 + Y1_QA + 128 * h + 64 * role, N1, Y1 + r0 * N1 + Y1_KA + 128 * h, Y1 + r0 * N1 + Y1_VA + 128 * h, N1,
                             8 * role, 0, qw, 0, 2 * qb + 2, exp2f(-2.0f * (float)(h + 1)) * LOG2E, nullptr, 0.0f, E);
        }
    }
}
__device__ __forceinline__ void attn_phase_b(Frame& F, const bf16* Y1, const bf16* QL, const unsigned long long* MASK, bf16* YC) {
    const int w = F.wave, qg = w & 3, role = w >> 2;
    for (int v = F.vcu; v < 256; v += F.G) {
        const int bh = v >> 3, s = v & 7, b = bh >> 2, hp = bh & 3, head = 2 * hp + role; const size_t r0 = (size_t)b * SEQ;
        for (int i = 0; i < 2; ++i) {
            const int qb = i == 0 ? s : 15 - s, q0 = 128 * qb, qw = q0 + 32 * qg;
            fa::Epi E; E.gate = Y1 + (r0 + qw) * N1 + Y1_GATE + 512 + 64 * head; E.gpitch = N1; E.out = YC + (r0 + qw) * DM + 512 + 64 * head; E.lam = 0.f; E.subg = nullptr;
            fa::attn_unit<1>(F.lds + RING_OFF, QL + (r0 + qw) * N2 + 128 * head, N2, QL + r0 * N2 + QL_KV, QL + r0 * N2 + QL_VP + 128 * hp, N2,
                             0, 2 * role, qw, 0, 2 * qb + 2, exp2f(-(float)(head + 1)) * LOG2E, MASK + (r0 + qw) * 32, 0.0f, E);
        }
    }
}
__device__ __forceinline__ void attn_phase_c(Frame& F, const Ptrs& P, const bf16* Y2, bf16* YC) {
    const int w = F.wave, qg = w & 3, g = w >> 2;
    for (int u = F.vcu; u < 512; u += F.G) {
        const int b = u >> 6, n = (u >> 2) & 15, r = u & 3, head = 4 * g + r, q0 = 128 * n, qw = q0 + 32 * qg; const size_t r0 = (size_t)b * SEQ;
        fa::Epi E; E.gate = Y2 + (r0 + qw) * N3 + Y2_GATE + 64 * head; E.gpitch = N3; E.out = YC + (r0 + qw) * DM + 64 * head; E.lam = 0.f; E.subg = nullptr;
        const int t_lo = (n == 0) ? 0 : 2 * n - 2, t_hi = 2 * n + 2;
        fa::attn_unit<2>(F.lds + RING_OFF, Y2 + (r0 + qw) * N3 + 64 * head, N3, Y2 + r0 * N3 + Y2_KC, Y2 + r0 * N3 + Y2_VC, N3,
                         8 * g, 2 * g, qw, t_lo, t_hi, exp2f(-(float)(head + 1)) * LOG2E, nullptr, P.in[18][head] * LOG2E, E);
    }
}

#ifndef FAST_A
#define FAST_A 1
#endif
#ifndef FAST_B
#define FAST_B 1
#endif
#ifndef FAST_C
#define FAST_C 1
#endif
#ifndef MK_PER_PHASE
#define MK_PER_PHASE 0
#endif
constexpr int N_PHASES = 12;
struct Args { const float* in[25]; float* out; unsigned char* ws; int ph_lo, ph_hi; };
static_assert(sizeof(Args) == 25 * 8 + 8 + 8 + 8, "Args has no padding");

__global__ void __launch_bounds__(NWAVES * 64, 2) mega_fwd(Args args) {
    extern __shared__ __attribute__((aligned(16))) unsigned char lds[];
    Frame F;
    F.lds = (LAS unsigned char*)lds;
    F.MISC = (volatile LAS unsigned*)(F.lds + MISC_OFF);
    F.tid = threadIdx.x; F.lane = F.tid & 63; F.wave = __builtin_amdgcn_readfirstlane(F.tid >> 6);
    F.G = gridDim.x; { const int bx = blockIdx.x; F.vcu = (F.G % 8 == 0) ? (bx % 8) * (F.G / 8) + bx / 8 : bx; }
    unsigned char* ws = args.ws;
    F.ctl = (gu32*)(ws + WS_CTL);
    Ptrs P;
#pragma unroll
    for (int i = 0; i < 25; ++i) P.in[i] = args.in[i];
    P.out = args.out; P.ws = ws;
    for (int u = F.tid; u < (LDS_BYTES - LDSCTL_OFF) / 4; u += NWAVES * 64) ((LAS unsigned*)(F.lds + LDSCTL_OFF))[u] = 0u;
    __syncthreads();
    XcdBarrier bar; bar.bar = (unsigned*)(F.ctl + CW_BAR); bar.x = 0; bar.st = nullptr;
    if (!MK_PER_PHASE) bar = xcd_barrier_post((unsigned*)(F.ctl + CW_BAR), F.MISC + 8);
#define GRID_BAR() do { if (!MK_PER_PHASE) xcd_barrier(bar); } while (0)
    const int lo = args.ph_lo, hi = args.ph_hi;
#define IN(k) (lo <= (k) && (k) < hi)
#define BOTH(k) (IN(k) && IN((k) + 1))

    bf16* W1T = (bf16*)(ws + WS_W1T); bf16* WO1T = (bf16*)(ws + WS_WO1T); bf16* W3T = (bf16*)(ws + WS_W3T); bf16* WO2T = (bf16*)(ws + WS_WO2T); bf16* W2T = (bf16*)(ws + WS_W2T);
    bf16* XN = (bf16*)(ws + WS_XN); bf16* Y1 = (bf16*)(ws + WS_Y1); bf16* QL = (bf16*)(ws + WS_QL); bf16* YC = (bf16*)(ws + WS_YC);
    unsigned long long* MASK = (unsigned long long*)(ws + WS_MASK);
    float* stats = (float*)(ws + WS_STATS); const float* mods = (const float*)(ws + WS_MODS);

    if (IN(0)) { p0_prologue(F, P); if (BOTH(0)) GRID_BAR(); }
    if (IN(1)) { xn_phase(F, P.in[0], P.in[4], mods, XN); if (BOTH(1)) GRID_BAR(); }
    if (IN(2)) {
        pg8::Gemm g{XN, W1T, M, N1, 1024, 1024, 1024}; pg8::StaticOrder S; S.init(M, N1, F.G, (int)blockIdx.x);
        pg8::EpiStoreBf16 E{Y1, N1, stats, 6};
        pg8::gemm_phase<pg8::EpiStoreBf16, pg8::StaticOrder, true, true>(F.lds + RING_OFF, g, S, E);
        if (BOTH(2)) GRID_BAR();
    }
    if (IN(3)) {
        pg8::Gemm g{Y1 + Y1_CQ, W2T, M, N2, 256, N1, 256}; pg8::StaticOrder S; S.init(M, N2, F.G, (int)blockIdx.x);
        pg8::EpiScaleBf16 E{QL, N2, stats, 5, EPS};
        pg8::gemm_phase<pg8::EpiScaleBf16, pg8::StaticOrder, true, true>(F.lds + RING_OFF, g, S, E);
        if (BOTH(3)) GRID_BAR();
    }
    if (IN(4)) { indexer_naive(F, Y1, QL, MASK); if (BOTH(4)) GRID_BAR(); }
    if (IN(5)) {
#if FAST_A
        attn_phase_a(F, P, Y1, YC);
#else
        diffattn_naive(F, P, Y1, YC);
#endif
        asm volatile("" ::: "memory"); __syncthreads();
#if FAST_B
        attn_phase_b(F, Y1, QL, MASK, YC);
#else
        dsa_naive(F, Y1, QL, MASK, YC);
#endif
        if (BOTH(5)) GRID_BAR(); }
    if (IN(6)) {
        pg8::Gemm g{YC, WO1T, M, 1024, 1024, 1024, 1024}; pg8::StaticOrder S; S.init(M, 1024, F.G, (int)blockIdx.x);
        pg8::EpiResid E{P.in[0], P.out, mods + 2048, 3072};
        pg8::gemm_phase<pg8::EpiResid, pg8::StaticOrder, false, true>(F.lds + RING_OFF, g, S, E);
        if (BOTH(6)) GRID_BAR();
    }
    if (IN(7)) { xn_phase(F, P.out, P.in[4] + 1024, mods + 8 * 3072, XN); if (BOTH(7)) GRID_BAR(); }
    if (IN(8)) {
        pg8::Gemm g{XN, W3T, M, N3, 1024, 1024, 1024}; pg8::StaticOrder S; S.init(M, N3, F.G, (int)blockIdx.x);
        pg8::EpiStoreBf16 E{Y1, N3, nullptr, -1};
        pg8::gemm_phase<pg8::EpiStoreBf16, pg8::StaticOrder, true, true>(F.lds + RING_OFF, g, S, E);
        if (BOTH(8)) GRID_BAR();
    }
    if (IN(9)) {
#if FAST_C
        attn_phase_c(F, P, Y1, YC);
#else
        swa_naive(F, P, Y1, YC); __syncthreads();
#endif
        conv_phase(F, P, Y1, YC); if (BOTH(9)) GRID_BAR(); }
    if (IN(10)) {
        pg8::Gemm g{YC, WO2T, M, 1024, 1024, 1024, 1024}; pg8::StaticOrder S; S.init(M, 1024, F.G, (int)blockIdx.x);
        pg8::EpiResid E{P.out, P.out, mods + 8 * 3072 + 2048, 3072};
        pg8::gemm_phase<pg8::EpiResid, pg8::StaticOrder, false, true>(F.lds + RING_OFF, g, S, E);
        if (BOTH(10)) GRID_BAR();
    }
    if (IN(11)) { final_norm_phase(F, P.out, P.in[24]); }
#undef IN
#undef BOTH
}

extern "C" void kernel_launch(void* const* d_in, const int* in_sizes, int n_in, void* d_out, int out_size, void* d_ws, size_t ws_size, hipStream_t stream) {
    static int grid = 0;
    if (grid == 0) {
        if (n_in != 25 || in_sizes[0] != M * DM || out_size != M * DM || ws_size < WS_END) { fprintf(stderr, "kernel_launch: unexpected shapes (n_in %d, in0 %d, out %d, ws %zu); nothing launched\n", n_in, n_in > 0 ? in_sizes[0] : -1, out_size, ws_size); grid = -1; return; }
        int dev = 0, cus = 0, per_cu = 0;
        if (hipGetDevice(&dev) != hipSuccess || hipDeviceGetAttribute(&cus, hipDeviceAttributeMultiprocessorCount, dev) != hipSuccess) { grid = -1; return; }
        if (hipFuncSetAttribute((const void*)mega_fwd, hipFuncAttributeMaxDynamicSharedMemorySize, LDS_BYTES) != hipSuccess) { fprintf(stderr, "kernel_launch: hipFuncSetAttribute failed\n"); grid = -1; return; }
        if (hipOccupancyMaxActiveBlocksPerMultiprocessor(&per_cu, (const void*)mega_fwd, NWAVES * 64, LDS_BYTES) != hipSuccess || per_cu < 1)
            fprintf(stderr, "kernel_launch: note: occupancy query reports %d workgroups per CU\n", per_cu);
        (void)hipGetLastError();
        grid = cus;
    }
    if (grid < 0) return;
    if (hipMemsetAsync((char*)d_ws + WS_CTL, 0, CTL_ZERO_BYTES, stream) != hipSuccess) { fprintf(stderr, "kernel_launch: hipMemsetAsync failed\n"); return; }
    Args a{};
    for (int i = 0; i < 25; ++i) a.in[i] = (const float*)d_in[i];
    a.out = (float*)d_out; a.ws = (unsigned char*)d_ws;
#if MK_PER_PHASE
    for (int ph = 0; ph < N_PHASES; ++ph) { a.ph_lo = ph; a.ph_hi = ph + 1; hipLaunchKernelGGL(mega_fwd, dim3(grid), dim3(NWAVES * 64), LDS_BYTES, stream, a); }
#else
    a.ph_lo = 0; a.ph_hi = N_PHASES;
    hipLaunchKernelGGL(mega_fwd, dim3(grid), dim3(NWAVES * 64), LDS_BYTES, stream, a);
#endif
    const hipError_t le = hipPeekAtLastError();
    if (le != hipSuccess) fprintf(stderr, "kernel_launch: launch failed: %s\n", hipGetErrorName(le));
}
```

```cpp
#include <hip/hip_runtime.h>
#include <cstdio>
#include <cstdint>
namespace pg8 {
#define PG8_LAS __attribute__((address_space(3)))
typedef unsigned short bf16_t;
typedef short bf16x8 __attribute__((ext_vector_type(8)));
typedef float f32x4 __attribute__((ext_vector_type(4)));
typedef unsigned u32x4 __attribute__((ext_vector_type(4)));
constexpr int BM = 256, BK = 64, HALF = 128, HTB = HALF * BK * 2  , STAGE_BYTES = 8 * HTB, NXCD = 8, WGM = 8;

__host__ __device__ __forceinline__ int lds_byte(int r, int c) { const int st = (r >> 4) * 2 + (c >> 5), rr = r & 15, cc = c & 31, ob = rr * 64 + cc * 2; return st * 1024 + (ob ^ (((ob >> 9) & 1) << 5)); }
__host__ __device__ __forceinline__ void stage_rc(int b, int& R, int& C) { const int st = b / 1024, sb = b % 1024, swz = sb ^ (((sb >> 9) & 1) << 5); R = (st >> 1) * 16 + swz / 64; C = (st & 1) * 32 + (swz % 64) / 2; }
__host__ __device__ __forceinline__ int perm32(int rho) { const int n = rho >> 4, i = rho & 15; return 8 * (i >> 2) + 4 * n + (i & 3); }

struct Unit { int pm, pn; };
struct Gemm { const bf16_t* A; const bf16_t* Bt; int M, N, K, lda, ldb; };

struct StaticOrder {
    int nM, nN, nwg, G, c;
    __host__ __device__ void init(int M, int N, int G_, int c_) { nM = M / BM; nN = N / BM; nwg = nM * nN; G = G_; c = c_; }
    __host__ __device__ bool next(int i, Unit& u) const {
        const long L = (long)i * G + c; if (L >= nwg) return false;
        int wgid = (int)L; { const int q = nwg / NXCD, r = nwg % NXCD, xcd = wgid % NXCD, off = wgid / NXCD; wgid = (xcd < r ? xcd * (q + 1) : r * (q + 1) + (xcd - r) * q) + off; }
        const int nig = WGM * nN, gid = wgid / nig, fm = gid * WGM, gsz = (nM - fm) < WGM ? (nM - fm) : WGM;
        u.pm = fm + ((wgid % nig) % gsz); u.pn = (wgid % nig) / gsz; return true;
    }
    __device__ __forceinline__ void a_ready(const Unit&) const {}
    __device__ __forceinline__ void done(const Unit&) const {}
};

__device__ __forceinline__ unsigned cvt_pk_bf16(float lo, float hi) { unsigned r; asm volatile("v_cvt_pk_bf16_f32 %0, %1, %2" : "=v"(r) : "v"(lo), "v"(hi)); return r; }

struct EpiStoreBf16 {
    static constexpr bool PERM = true, AFTER_DRAIN = false;
    bf16_t* O; int ldc; float* stats; int stat_pn;
    __device__ __forceinline__ void operator()(const f32x4 (&acc)[2][2][4][2], const Unit& u, int wr, int wc, int fr, int fq) const {
        const int row0 = u.pm * BM + wr * 64 + fr, col0 = u.pn * BM + wc * 32 + 8 * fq;
#pragma unroll
        for (int ai = 0; ai < 2; ++ai)
#pragma unroll
            for (int m = 0; m < 4; ++m) { bf16_t* rowp = O + (size_t)(row0 + ai * HALF + m * 16) * ldc + col0;
#pragma unroll
                for (int bj = 0; bj < 2; ++bj) { const f32x4 v0 = acc[ai][bj][m][0], v1 = acc[ai][bj][m][1];
                    u32x4 w; w.x = cvt_pk_bf16(v0[0], v0[1]); w.y = cvt_pk_bf16(v0[2], v0[3]); w.z = cvt_pk_bf16(v1[0], v1[1]); w.w = cvt_pk_bf16(v1[2], v1[3]);
                    *(u32x4*)(rowp + bj * HALF) = w; } }
        if (stats != nullptr && u.pn == stat_pn) {
#pragma unroll
            for (int ai = 0; ai < 2; ++ai)
#pragma unroll
                for (int m = 0; m < 4; ++m)
#pragma unroll
                    for (int bj = 0; bj < 2; ++bj) { const f32x4 v0 = acc[ai][bj][m][0], v1 = acc[ai][bj][m][1];
                        float s = (v0[0] * v0[0] + v0[1] * v0[1]) + (v0[2] * v0[2] + v0[3] * v0[3]) + (v1[0] * v1[0] + v1[1] * v1[1]) + (v1[2] * v1[2] + v1[3] * v1[3]);
                        s += __shfl_xor(s, 16); s += __shfl_xor(s, 32);
                        if (fq == 0) atomicAdd(stats + (size_t)(row0 + ai * HALF + m * 16) * 2 + bj, s); }
        }
    }
};
struct EpiScaleBf16 {
    static constexpr bool PERM = true, AFTER_DRAIN = false;
    bf16_t* O; int ldc; const float* stats; int pn_split; float eps;
    __device__ __forceinline__ void operator()(const f32x4 (&acc)[2][2][4][2], const Unit& u, int wr, int wc, int fr, int fq) const {
        const int row0 = u.pm * BM + wr * 64 + fr, col0 = u.pn * BM + wc * 32 + 8 * fq, si = (u.pn < pn_split) ? 0 : 1;
#pragma unroll
        for (int ai = 0; ai < 2; ++ai)
#pragma unroll
            for (int m = 0; m < 4; ++m) { const int row = row0 + ai * HALF + m * 16; bf16_t* rowp = O + (size_t)row * ldc + col0;
                const float rs = 1.0f / sqrtf(stats[(size_t)row * 2 + si] * (1.0f / 128.0f) + eps);
#pragma unroll
                for (int bj = 0; bj < 2; ++bj) { const f32x4 v0 = acc[ai][bj][m][0] * rs, v1 = acc[ai][bj][m][1] * rs;
                    u32x4 w; w.x = cvt_pk_bf16(v0[0], v0[1]); w.y = cvt_pk_bf16(v0[2], v0[3]); w.z = cvt_pk_bf16(v1[0], v1[1]); w.w = cvt_pk_bf16(v1[2], v1[3]);
                    *(u32x4*)(rowp + bj * HALF) = w; } }
    }
};
struct EpiResid {
    static constexpr bool PERM = false, AFTER_DRAIN = false;
    const float* resid; float* out; const float* gate; int gstride;
    __device__ __forceinline__ void operator()(const f32x4 (&acc)[2][2][4][2], const Unit& u, int wr, int wc, int fr, int fq) const {
        const int row0 = u.pm * BM + wr * 64 + fr, col0 = u.pn * BM + wc * 32 + 4 * fq;
        const float* gp = gate + (size_t)(u.pm >> 3) * gstride + col0;
        f32x4 gv[2][2];
#pragma unroll
        for (int bj = 0; bj < 2; ++bj)
#pragma unroll
            for (int n = 0; n < 2; ++n) gv[bj][n] = *(const f32x4*)(gp + bj * HALF + n * 16);
#pragma unroll
        for (int ai = 0; ai < 2; ++ai)
#pragma unroll
            for (int m = 0; m < 4; ++m) { const size_t off = (size_t)(row0 + ai * HALF + m * 16) * 1024 + col0;
#pragma unroll
                for (int bj = 0; bj < 2; ++bj)
#pragma unroll
                    for (int n = 0; n < 2; ++n) { const f32x4 r = *(const f32x4*)(resid + off + bj * HALF + n * 16); *(f32x4*)(out + off + bj * HALF + n * 16) = r + gv[bj][n] * acc[ai][bj][m][n]; }
                if (m & 1) asm volatile("" ::: "memory"); }
    }
};

template <class Epi, class Sched, bool ALIGN_EPI = false, bool SP2 = false>
__device__ __forceinline__ void gemm_phase(PG8_LAS unsigned char* lds, const Gemm g, const Sched& S, const Epi& E) {
    const int tid = threadIdx.x, wid = __builtin_amdgcn_readfirstlane(tid >> 6), lane = tid & 63, wr = wid >> 2, wc = wid & 3, fr = lane & 15, fq = lane >> 4;
    const int K = g.K, nt = K / BK;
    unsigned voffA[2], voffB[2];
#pragma unroll
    for (int i = 0; i < 2; ++i) { int R, C; stage_rc(tid * 16 + i * 8192, R, C); const int Rb = Epi::PERM ? ((R & ~31) + perm32(R & 31)) : R;
        voffA[i] = (unsigned)(R * g.lda + C) * 2u; voffB[i] = (unsigned)(Rb * g.ldb + C) * 2u; }
    const size_t kstep = (size_t)(BK * 2);
    const size_t hstepA = (size_t)HALF * g.lda * 2, hstepB = (size_t)HALF * g.ldb * 2;
    const size_t tstepA = 2 * hstepA, tstepB = 2 * hstepB;
    const unsigned ldsw = (unsigned)wid * 1024u;
    const int aoff = lds_byte(wr * 64 + fr, fq * 8), boff = lds_byte(wc * 32 + fr, fq * 8);
#define PG8_SA(b, h) (((b) * 2 + (h)) * HTB)
#define PG8_SB(b, h) ((4 + (b) * 2 + (h)) * HTB)
#define PG8_STAGE(bufoff, gbase, voff) do { _Pragma("unroll") for (int _i = 0; _i < 2; ++_i) \
        __builtin_amdgcn_global_load_lds((const unsigned*)((const char*)(gbase) + (voff)[_i]), (PG8_LAS unsigned*)(lds + (bufoff) + ldsw + _i * 8192), 16, 0, 0); } while (0)
#define PG8_LDA(dst, b, h) do { _Pragma("unroll") for (int m = 0; m < 4; ++m) _Pragma("unroll") for (int k = 0; k < 2; ++k) dst[m][k] = *(const PG8_LAS bf16x8*)(lds + PG8_SA(b, h) + aoff + m * 2048 + k * 1024); } while (0)
#define PG8_LDB(dst, b, h) do { _Pragma("unroll") for (int n = 0; n < 2; ++n) _Pragma("unroll") for (int k = 0; k < 2; ++k) dst[n][k] = *(const PG8_LAS bf16x8*)(lds + PG8_SB(b, h) + boff + n * 2048 + k * 1024); } while (0)
#define PG8_MMA(ai, bj, At, Bt) do { __builtin_amdgcn_s_setprio(1); _Pragma("unroll") for (int m = 0; m < 4; ++m) _Pragma("unroll") for (int n = 0; n < 2; ++n) _Pragma("unroll") for (int k = 0; k < 2; ++k) \
        acc[ai][bj][m][n] = __builtin_amdgcn_mfma_f32_16x16x32_bf16(Bt[n][k], At[m][k], acc[ai][bj][m][n], 0, 0, 0); __builtin_amdgcn_s_setprio(0); } while (0)
#define PG8_WAIT_V(n) asm volatile("s_waitcnt vmcnt(" #n ")" ::: "memory")
#define PG8_WAIT_L(n) asm volatile("s_waitcnt lgkmcnt(" #n ")" ::: "memory")
#define PG8_BAR __builtin_amdgcn_s_barrier()
#define PG8_SCHED __builtin_amdgcn_sched_barrier(0)
    Unit cur, nxt; int ui = 0;
    if (!S.next(0, cur)) return;
    f32x4 acc[2][2][4][2];
#pragma unroll
    for (int a = 0; a < 2; ++a)
#pragma unroll
        for (int b = 0; b < 2; ++b)
#pragma unroll
            for (int m = 0; m < 4; ++m)
#pragma unroll
                for (int n = 0; n < 2; ++n) acc[a][b][m][n] = (f32x4){0.f, 0.f, 0.f, 0.f};
    bf16x8 At[4][2], B0[2][2], B1[2][2];
    const char* cA = (const char*)g.A + (size_t)cur.pm * tstepA; const char* cB = (const char*)g.Bt + (size_t)cur.pn * tstepB;
    S.a_ready(cur);
    if constexpr (SP2) {
        PG8_STAGE(PG8_SB(0, 0), cB, voffB); PG8_STAGE(PG8_SB(0, 1), cB + hstepB, voffB); PG8_STAGE(PG8_SA(0, 0), cA, voffA); PG8_STAGE(PG8_SA(0, 1), cA + hstepA, voffA);
        if (wr == 1) PG8_BAR;
        PG8_WAIT_V(2); PG8_BAR;
        PG8_STAGE(PG8_SB(1, 0), cB + kstep, voffB); PG8_STAGE(PG8_SA(1, 0), cA + kstep, voffA); PG8_STAGE(PG8_SB(1, 1), cB + hstepB + kstep, voffB);
        PG8_WAIT_V(6); PG8_BAR;
    } else {
        PG8_STAGE(PG8_SB(0, 0), cB, voffB); PG8_STAGE(PG8_SA(0, 0), cA, voffA); PG8_STAGE(PG8_SB(0, 1), cB + hstepB, voffB); PG8_STAGE(PG8_SA(0, 1), cA + hstepA, voffA);
        if (wr == 1) PG8_BAR;
        PG8_WAIT_V(4); PG8_BAR;
        PG8_STAGE(PG8_SB(1, 0), cB + kstep, voffB); PG8_STAGE(PG8_SA(1, 0), cA + kstep, voffA); PG8_STAGE(PG8_SB(1, 1), cB + hstepB + kstep, voffB);
        PG8_WAIT_V(6); PG8_BAR;
    }
    for (;;) {
        const bool has_next = S.next(ui + 1, nxt);
        const char* nA = has_next ? (const char*)g.A + (size_t)nxt.pm * tstepA : cA; const char* nB = has_next ? (const char*)g.Bt + (size_t)nxt.pn * tstepB : cB;
        for (int t = 0; t < nt; t += 2) {
            const bool last = (t == nt - 2);
            const char* a1 = cA + (size_t)(t + 1) * kstep;
            const char* a2 = last ? nA : cA + (size_t)(t + 2) * kstep; const char* b2 = last ? nB : cB + (size_t)(t + 2) * kstep;
            const char* a3 = a2 + kstep; const char* b3 = b2 + kstep;
            if (last && has_next) S.a_ready(nxt);
            if constexpr (SP2) {
            PG8_LDB(B0, 0, 0); PG8_LDB(B1, 0, 1); PG8_SCHED; PG8_LDA(At, 0, 0); PG8_STAGE(PG8_SA(1, 1), a1 + hstepA, voffA);
            PG8_WAIT_V(8); PG8_WAIT_L(0); PG8_BAR; PG8_MMA(0, 0, At, B0); PG8_MMA(0, 1, At, B1); PG8_BAR; PG8_SCHED;
            PG8_LDA(At, 0, 1); PG8_STAGE(PG8_SB(0, 0), b2, voffB); PG8_STAGE(PG8_SB(0, 1), b2 + hstepB, voffB); PG8_STAGE(PG8_SA(0, 0), a2, voffA);
            PG8_WAIT_V(8); PG8_WAIT_L(0); PG8_BAR; PG8_MMA(1, 0, At, B0); PG8_MMA(1, 1, At, B1); PG8_BAR; PG8_SCHED;
            PG8_LDB(B0, 1, 0); PG8_LDB(B1, 1, 1); PG8_SCHED; PG8_LDA(At, 1, 0); PG8_STAGE(PG8_SA(0, 1), a2 + hstepA, voffA);
            PG8_WAIT_V(8); PG8_WAIT_L(0); PG8_BAR; PG8_MMA(0, 0, At, B0); PG8_MMA(0, 1, At, B1); PG8_BAR; PG8_SCHED;
            PG8_LDA(At, 1, 1); PG8_STAGE(PG8_SB(1, 0), b3, voffB); PG8_STAGE(PG8_SB(1, 1), b3 + hstepB, voffB); PG8_STAGE(PG8_SA(1, 0), a3, voffA);
            PG8_WAIT_V(8); PG8_WAIT_L(0); PG8_BAR; PG8_MMA(1, 0, At, B0); PG8_MMA(1, 1, At, B1); PG8_BAR; PG8_SCHED;
            } else {
            PG8_LDB(B0, 0, 0); PG8_SCHED; PG8_LDA(At, 0, 0); PG8_STAGE(PG8_SA(1, 1), a1 + hstepA, voffA);
            PG8_WAIT_L(8); PG8_BAR; PG8_WAIT_L(0); PG8_MMA(0, 0, At, B0); PG8_BAR; PG8_SCHED;
            PG8_LDB(B1, 0, 1); PG8_STAGE(PG8_SB(0, 0), b2, voffB);
            PG8_BAR; PG8_WAIT_L(0); PG8_MMA(0, 1, At, B1); PG8_BAR;
            PG8_LDA(At, 0, 1); PG8_STAGE(PG8_SA(0, 0), a2, voffA);
            PG8_BAR; PG8_WAIT_L(0); PG8_MMA(1, 0, At, B0); PG8_BAR; PG8_SCHED;
            PG8_STAGE(PG8_SB(0, 1), b2 + hstepB, voffB);
            PG8_WAIT_V(6); PG8_BAR; PG8_MMA(1, 1, At, B1); PG8_BAR;
            PG8_LDB(B0, 1, 0); PG8_SCHED; PG8_LDA(At, 1, 0); PG8_STAGE(PG8_SA(0, 1), a2 + hstepA, voffA);
            PG8_WAIT_L(8); PG8_BAR; PG8_WAIT_L(0); PG8_MMA(0, 0, At, B0); PG8_BAR; PG8_SCHED;
            PG8_LDB(B1, 1, 1); PG8_STAGE(PG8_SB(1, 0), b3, voffB);
            PG8_BAR; PG8_WAIT_L(0); PG8_MMA(0, 1, At, B1); PG8_BAR;
            PG8_LDA(At, 1, 1); PG8_STAGE(PG8_SA(1, 0), a3, voffA);
            PG8_BAR; PG8_WAIT_L(0); PG8_MMA(1, 0, At, B0); PG8_BAR; PG8_SCHED;
            PG8_STAGE(PG8_SB(1, 1), b3 + hstepB, voffB);
            PG8_WAIT_V(6); PG8_BAR; PG8_MMA(1, 1, At, B1); PG8_BAR;
            }
        }
        if constexpr (ALIGN_EPI) { if (wr == 0) PG8_BAR; }
        if constexpr (!Epi::AFTER_DRAIN) { E(acc, cur, wr, wc, fr, fq); S.done(cur); }
        if (!has_next) break;
#pragma unroll
        for (int a = 0; a < 2; ++a)
#pragma unroll
            for (int b = 0; b < 2; ++b)
#pragma unroll
                for (int m = 0; m < 4; ++m)
#pragma unroll
                    for (int n = 0; n < 2; ++n) acc[a][b][m][n] = (f32x4){0.f, 0.f, 0.f, 0.f};
        cur = nxt; cA = nA; cB = nB; ++ui;
        if constexpr (ALIGN_EPI) { if (wr == 1) PG8_BAR; }
    }
    PG8_WAIT_V(0);
    if constexpr (!ALIGN_EPI) { if (wr == 0) PG8_BAR; }
    PG8_BAR;
    if constexpr (Epi::AFTER_DRAIN) { E.fused(acc, cur, wr, wc, fr, fq, lds, wid, lane); S.done(cur); }
#undef PG8_SA
#undef PG8_SB
#undef PG8_STAGE
#undef PG8_LDA
#undef PG8_LDB
#undef PG8_MMA
#undef PG8_WAIT_V
#undef PG8_WAIT_L
#undef PG8_BAR
#undef PG8_SCHED
}
}

constexpr int NWAVES = 8;
constexpr int BATCH = 8, SEQ = 2048, DM = 1024, M = BATCH * SEQ;
constexpr int N1 = 3072;
constexpr int N1SRC = 2856;
constexpr int Y1_QA = 0, Y1_KA = 512, Y1_VA = 1024, Y1_CQ = 1536, Y1_KIDX = 1792, Y1_WIDX = 1824, Y1_GATE = 2048;
constexpr int N2 = 2048;
constexpr int QL_QIDX = 1024, QL_KV = 1280, QL_VP = 1408;
constexpr int N3 = 2816;
constexpr int Y2_KC = 512, Y2_VC = 640, Y2_DVAL = 768, Y2_DGATE = 1280, Y2_GATE = 1792;
constexpr float EPS = 1e-6f, LOG2E = 1.4426950408889634f;
constexpr float CQK = 0.125f * LOG2E;
constexpr float CQL = 0.08838834764831845f * LOG2E;
constexpr float LAM_INIT = 0.2f;
constexpr int TOPK = 256;

constexpr size_t MiB = 1u << 20;
constexpr size_t WS_CTL = 0, CTL_ZERO_BYTES = 1 * MiB;
constexpr size_t WS_STATS = 512 * 1024;
constexpr size_t WS_MODS = 1 * MiB;
constexpr size_t WS_W1T = 2 * MiB;
constexpr size_t WS_WO1T = 8 * MiB;
constexpr size_t WS_W3T = 10 * MiB;
constexpr size_t WS_WO2T = 16 * MiB;
constexpr size_t WS_W2T = 18 * MiB;
constexpr size_t WS_XN = 20 * MiB;
constexpr size_t WS_Y1 = 52 * MiB;
constexpr size_t WS_QL = 148 * MiB;
constexpr size_t WS_YC = 212 * MiB;
constexpr size_t WS_MASK = 244 * MiB;
constexpr size_t WS_END = 248 * MiB;
constexpr int CW_BAR = 4096;

constexpr int RING_OFF = 0, RING_BYTES = 135168;
constexpr int LDSCTL_OFF = RING_BYTES, MISC_OFF = LDSCTL_OFF + 320;
constexpr int LDS_BYTES = 147456;

#define GAS __attribute__((address_space(1)))
#define LAS __attribute__((address_space(3)))
typedef unsigned short bf16;
typedef unsigned v4u __attribute__((ext_vector_type(4)));
typedef float f32x4 __attribute__((ext_vector_type(4)));
typedef short bf16x8 __attribute__((ext_vector_type(8)));
typedef GAS unsigned gu32;
typedef GAS unsigned long long gu64;
#define RLX_AGENT __ATOMIC_RELAXED, __HIP_MEMORY_SCOPE_AGENT
#define LDS_WAIT() asm volatile("s_waitcnt lgkmcnt(0)" ::: "memory")
#define VM_WAIT() asm volatile("s_waitcnt vmcnt(0)" ::: "memory")
__device__ __forceinline__ unsigned long long rt() { return __builtin_amdgcn_s_memrealtime(); }
__device__ __forceinline__ unsigned f2bf(float f) { unsigned u = __builtin_bit_cast(unsigned, f); return (u + 0x7fffu + ((u >> 16) & 1u)) >> 16; }
__device__ __forceinline__ unsigned pk2(float lo, float hi) { return f2bf(lo) | (f2bf(hi) << 16); }

#define XB_TMO      128
#define XB_XCNT(j)  (256  + 64 * (j))
#define XB_XSUB(j)  (1280 + 64 * (j))
#define XB_XGEN(j)  (2304 + 64 * (j))
#define XB_TOP      3328
#define XB_TOPGEN   3392
#define XCD_BAR_WORDS 3456
#define XB_SPIN_CAP (1u << 18)

__device__ __forceinline__ unsigned xb_ld(unsigned* p)              { return __hip_atomic_load(p, __ATOMIC_RELAXED, __HIP_MEMORY_SCOPE_AGENT); }
__device__ __forceinline__ unsigned xb_add(unsigned* p, unsigned v) { return __hip_atomic_fetch_add(p, v, __ATOMIC_RELAXED, __HIP_MEMORY_SCOPE_AGENT); }
__device__ __forceinline__ unsigned xb_xcc_id() { return (unsigned)__builtin_amdgcn_s_getreg((3 << 11) | 20) & 0xFu; }
#define XB_SPIN(cond, bar) do { unsigned _sp = 0; while (cond) { __builtin_amdgcn_s_sleep(1); \
    if ((++_sp & 255u) == 0u) { if (xb_ld(&(bar)[XB_TMO])) break; if (_sp > XB_SPIN_CAP) { atomicAdd(&(bar)[XB_TMO], 1u); break; } } } } while (0)

struct XcdBarrier {
    unsigned* bar; unsigned x;
    volatile LAS unsigned* st;
};

__device__ __forceinline__ XcdBarrier xcd_barrier_post(unsigned* bar, volatile LAS unsigned* st) {
    XcdBarrier b; b.bar = bar; b.x = xb_xcc_id(); b.st = st;
    if (threadIdx.x == 0) (void)xb_add(&bar[XB_XCNT(b.x)], 1u);
    return b;
}
__device__ __forceinline__ void xcd_barrier_complete(unsigned* bar, unsigned x, unsigned& nloc, unsigned& nx) {
    const unsigned G = gridDim.x * gridDim.y * gridDim.z;
    unsigned sum, cnt, mine, sp = 0u;
    for (;;) {
        sum = 0u; cnt = 0u; mine = 0u;
#pragma unroll
        for (unsigned j = 0; j < 16; ++j) { const unsigned c = xb_ld(&bar[XB_XCNT(j)]); sum += c; cnt += (c > 0u) ? 1u : 0u; mine = (j == x) ? c : mine; }
        if (sum == G) break;
        __builtin_amdgcn_s_sleep(1);
        if ((++sp & 255u) == 0u) { if (xb_ld(&bar[XB_TMO])) break; if (sp > XB_SPIN_CAP) { atomicAdd(&bar[XB_TMO], 1u); break; } }
    }
    nloc = mine > 0u ? mine : 1u; nx = cnt > 0u ? cnt : 1u;
}

__device__ __forceinline__ void xcd_barrier(const XcdBarrier& b) {
    asm volatile("s_waitcnt vmcnt(0)" ::: "memory");
    __syncthreads();
    if (threadIdx.x == 0) {
        unsigned* bar = b.bar;
        __builtin_amdgcn_s_waitcnt(0);
        unsigned nloc = b.st[0], nx = b.st[1];
        if (nloc == 0u) { xcd_barrier_complete(bar, b.x, nloc, nx); b.st[0] = nloc; b.st[1] = nx; }
        const unsigned old = xb_add(&bar[XB_XSUB(b.x)], 1u);
        const unsigned gen = old / nloc;
        if (old + 1u == (gen + 1u) * nloc) {
            __builtin_amdgcn_fence(__ATOMIC_RELEASE, "agent");
            asm volatile("s_waitcnt vmcnt(0)" ::: "memory");
            const unsigned og = xb_add(&bar[XB_TOP], 1u);
            const unsigned tg = og / nx;
            if (og + 1u == (tg + 1u) * nx) xb_add(&bar[XB_TOPGEN], 1u);
            else XB_SPIN(xb_ld(&bar[XB_TOPGEN]) == tg, bar);
            __builtin_amdgcn_fence(__ATOMIC_ACQUIRE, "agent");
            xb_add(&bar[XB_XGEN(b.x)], 1u);
            asm volatile("s_waitcnt vmcnt(0)" ::: "memory");
        } else {
            XB_SPIN(xb_ld(&bar[XB_XGEN(b.x)]) == gen, bar);
            __builtin_amdgcn_fence(__ATOMIC_ACQUIRE, "agent");
            asm volatile("s_waitcnt vmcnt(0)" ::: "memory");
        }
    }
    __syncthreads();
}


struct Frame {
    LAS unsigned char* lds;
    volatile LAS unsigned* MISC;
    gu32* ctl;
    int tid, lane, wave;
    int vcu, G;
};
__device__ __forceinline__ float wave_sum(float v) {
#pragma unroll
    for (int o = 1; o < 64; o <<= 1) v += __shfl_xor(v, o);
    return v;
}
__device__ __forceinline__ float wave_max(float v) {
#pragma unroll
    for (int o = 1; o < 64; o <<= 1) v = fmaxf(v, __shfl_xor(v, o));
    return v;
}
__device__ __forceinline__ float bflo(unsigned w) { return __uint_as_float(w << 16); }
__device__ __forceinline__ float bfhi(unsigned w) { return __uint_as_float(w & 0xffff0000u); }
__device__ __forceinline__ float bf2f(bf16 u) { return __uint_as_float((unsigned)u << 16); }
__device__ __forceinline__ float silu_f(float g) { return g / (1.0f + __expf(-g)); }

template <int KIND> __device__ __forceinline__ int map_col(int d, float& sc) {
    sc = 1.0f;
    if (KIND == 0) { if (d < 512) sc = CQK; if (d < 1832) return d; if (d < 2048) return -1; return d - 216; }
    if (KIND == 2) { if (d < 512) sc = CQK; return d; }
    return d;
}
template <int KIND> __device__ __forceinline__ void p0_transpose_item(const float* W, int K, int Nsrc, int Ndst, bf16* WT, LAS float* scr, int item, int lane) {
    const int nblk = Ndst / 32, kb = item / nblk, nb = item % nblk, k0 = 64 * kb, n0 = 32 * nb;
    float sc; const int src = map_col<KIND>(n0 + (lane & 31), sc);
#pragma unroll 8
    for (int i = 0; i < 32; ++i) { const int kk = 2 * i + (lane >> 5); scr[kk * 33 + (lane & 31)] = (src >= 0) ? W[(size_t)(k0 + kk) * Nsrc + src] * sc : 0.0f; }
    LDS_WAIT(); asm volatile("" ::: "memory");
    const int c = lane & 7;
#pragma unroll
    for (int j = 0; j < 4; ++j) { const int n = (lane >> 3) + 8 * j; const LAS float* s = scr + (8 * c) * 33 + n;
        v4u o; o.x = pk2(s[0 * 33], s[1 * 33]); o.y = pk2(s[2 * 33], s[3 * 33]); o.z = pk2(s[4 * 33], s[5 * 33]); o.w = pk2(s[6 * 33], s[7 * 33]);
        *(GAS v4u*)(WT + (size_t)(n0 + n) * K + k0 + 8 * c) = o; }
    LDS_WAIT(); asm volatile("" ::: "memory");
}
struct Ptrs {
    const float* in[25]; float* out; unsigned char* ws;
};
__device__ __forceinline__ void p0_prologue(Frame& F, const Ptrs& P) {
    LAS float* scr = (LAS float*)(F.lds + RING_OFF + F.wave * 16384);
    const int gw = F.vcu * NWAVES + F.wave, NGW = F.G * NWAVES;
    bf16* W1T = (bf16*)(P.ws + WS_W1T); bf16* WO1T = (bf16*)(P.ws + WS_WO1T); bf16* W3T = (bf16*)(P.ws + WS_W3T); bf16* WO2T = (bf16*)(P.ws + WS_WO2T); bf16* W2T = (bf16*)(P.ws + WS_W2T);
    constexpr int I_1 = 16 * (N1 / 32), I_O = 16 * 32, I_3 = 16 * (N3 / 32);
    constexpr int NITEMS = I_1 + I_O + I_3 + I_O;
    for (int it = gw; it < NITEMS; it += NGW) {
        int r = it;
        if (r < I_1) { p0_transpose_item<0>(P.in[5], 1024, N1SRC, N1, W1T, scr, r, F.lane); continue; } r -= I_1;
        if (r < I_O) { p0_transpose_item<1>(P.in[16], 1024, 1024, 1024, WO1T, scr, r, F.lane); continue; } r -= I_O;
        if (r < I_3) { p0_transpose_item<2>(P.in[17], 1024, N3, N3, W3T, scr, r, F.lane); continue; } r -= I_3;
        p0_transpose_item<1>(P.in[23], 1024, 1024, 1024, WO2T, scr, r, F.lane);
    }
    {
        const float* gq = P.in[6]; const float* gkv = P.in[7]; const float* wuq = P.in[8]; const float* wqi = P.in[9]; const float* wuv = P.in[10];
        for (int e = (int)blockIdx.x * 512 + F.tid; e < N2 * 256; e += F.G * 512) {
            const int n = e >> 8, k = e & 255; float v = 0.0f;
            if (n < 1024) { if (k < 128) v = gq[k] * wuq[(size_t)(k * 8 + (n >> 7)) * 128 + (n & 127)] * CQL; }
            else if (n < 1280) { const int j = n - 1024; if (k < 128) v = gq[k] * wqi[(size_t)(k * 8 + (j >> 5)) * 32 + (j & 31)]; }
            else if (n < 1408) { const int j = n - 1280; if (k == 128 + j) v = gkv[j]; }
            else if (n < 1920) { const int j = n - 1408; if (k >= 128) v = gkv[k - 128] * wuv[(size_t)((j >> 6) * 128 + (k - 128)) * 64 + (j & 63)]; }
            W2T[e] = (bf16)f2bf(v);
        }
    }
    __syncthreads();
    {
        LAS float* sl = (LAS float*)(F.lds + RING_OFF);
        LAS float* red = sl + 8192;
        const float* c = P.in[1]; const float* adaw = P.in[2]; const float* adab = P.in[3]; float* mods = (float*)(P.ws + WS_MODS);
        bool loaded = false;
        for (int it = (int)blockIdx.x; it < 96; it += F.G) {
            if (!loaded) { for (int i = F.tid; i < 8192; i += 512) sl[i] = silu_f(c[i]); loaded = true; __syncthreads(); }
            const int l = it / 48, n0 = (it % 48) * 64, col = F.tid & 63, kg = F.tid >> 6;
            float acc[8];
#pragma unroll
            for (int b = 0; b < 8; ++b) acc[b] = 0.0f;
            const float* wp = adaw + ((size_t)l * 1024 + kg * 128) * 3072 + n0 + col;
            for (int k = 0; k < 128; ++k) { const float w = wp[(size_t)k * 3072];
#pragma unroll
                for (int b = 0; b < 8; ++b) acc[b] += sl[b * 1024 + kg * 128 + k] * w; }
#pragma unroll
            for (int b = 0; b < 8; ++b) red[(kg * 8 + b) * 64 + col] = acc[b];
            __syncthreads();
            { const int b = F.tid >> 6; float s = 0.0f;
#pragma unroll
              for (int g2 = 0; g2 < 8; ++g2) s += red[(g2 * 8 + b) * 64 + col];
              mods[((size_t)l * 8 + b) * 3072 + n0 + col] = s + adab[l * 3072 + n0 + col]; }
            __syncthreads();
        }
    }
}

__device__ __forceinline__ void xn_phase(Frame& F, const float* xin, const float* g, const float* mods_l, bf16* XN) {
    const int gw = F.vcu * NWAVES + F.wave, NGW = F.G * NWAVES;
    for (int m = gw; m < M; m += NGW) {
        const int b = m >> 11;
        const GAS f32x4* xr = (const GAS f32x4*)(xin + (size_t)m * DM) + F.lane;
        f32x4 v[4]; float s = 0.f;
#pragma unroll
        for (int j = 0; j < 4; ++j) { v[j] = xr[64 * j]; s += (v[j].x * v[j].x + v[j].y * v[j].y) + (v[j].z * v[j].z + v[j].w * v[j].w); }
        const float rstd = 1.0f / sqrtf(wave_sum(s) * (1.0f / DM) + EPS);
        GAS unsigned long long* o8 = (GAS unsigned long long*)(XN + (size_t)m * DM) + F.lane;
#pragma unroll
        for (int j = 0; j < 4; ++j) { const int col = 4 * F.lane + 256 * j;
            const f32x4 gv = *(const f32x4*)(g + col), sc = *(const f32x4*)(mods_l + (size_t)b * 3072 + 1024 + col), sh = *(const f32x4*)(mods_l + (size_t)b * 3072 + col);
            const f32x4 h = v[j] * rstd * gv * (sc + 1.0f) + sh;
            o8[64 * j] = (unsigned long long)pk2(h.x, h.y) | ((unsigned long long)pk2(h.z, h.w) << 32); }
    }
}
__device__ __forceinline__ void final_norm_phase(Frame& F, float* x, const float* g) {
    const int gw = F.vcu * NWAVES + F.wave, NGW = F.G * NWAVES;
    for (int m = gw; m < M; m += NGW) {
        GAS f32x4* xr = (GAS f32x4*)(x + (size_t)m * DM) + F.lane;
        f32x4 v[4]; float s = 0.f;
#pragma unroll
        for (int j = 0; j < 4; ++j) { v[j] = xr[64 * j]; s += (v[j].x * v[j].x + v[j].y * v[j].y) + (v[j].z * v[j].z + v[j].w * v[j].w); }
        const float rstd = 1.0f / sqrtf(wave_sum(s) * (1.0f / DM) + EPS);
#pragma unroll
        for (int j = 0; j < 4; ++j) { const f32x4 gv = *(const f32x4*)(g + 4 * F.lane + 256 * j); xr[64 * j] = v[j] * rstd * gv; }
    }
}

__device__ __forceinline__ unsigned long long lowest_n_bits(unsigned long long e, int n) {
    unsigned long long r = 0ull;
    while (n > 0 && e) { const unsigned long long b = e & (0ull - e); r |= b; e ^= b; --n; }
    return r;
}
__device__ __forceinline__ unsigned long long topk_select(const unsigned (&keyv)[32], int lane) {
    unsigned T = 0u;
    for (int bit = 31; bit >= 0; --bit) {
        const unsigned cand = T | (1u << bit); int cnt = 0;
#pragma unroll
        for (int i = 0; i < 32; ++i) cnt += __popcll(__ballot(keyv[i] >= cand));
        if (cnt >= TOPK) T = cand;
    }
    int cgt = 0;
#pragma unroll
    for (int i = 0; i < 32; ++i) cgt += __popcll(__ballot(keyv[i] > T));
    int need = TOPK - cgt;
    unsigned long long mine = 0ull;
#pragma unroll
    for (int i = 0; i < 32; ++i) {
        const unsigned long long g = __ballot(keyv[i] > T), e = __ballot(keyv[i] == T);
        const int ne = __popcll(e);
        unsigned long long take;
        if (ne <= need) { take = e; need -= ne; } else { take = lowest_n_bits(e, need); need = 0; }
        const unsigned long long word = g | take;
        mine = (lane == i) ? word : mine;
    }
    return mine;
}
__device__ __forceinline__ unsigned sort_key(float v) { const unsigned u = __float_as_uint(v); return (u & 0x80000000u) ? ~u : (u | 0x80000000u); }

__device__ __forceinline__ void indexer_naive(Frame& F, const bf16* Y1, const bf16* QL, unsigned long long* MASK) {
    const int gw = F.vcu * NWAVES + F.wave, NGW = F.G * NWAVES, lane = F.lane;
    LAS float* qs = (LAS float*)(F.lds + RING_OFF + F.wave * 9216);
    LAS float* sc = qs + 256;
    for (int row = gw; row < M; row += NGW) {
        const int b = row >> 11, q = row & 2047;
        { const uint2 w2 = *(const uint2*)(QL + (size_t)row * N2 + QL_QIDX + 4 * lane);
          qs[4 * lane + 0] = bflo(w2.x); qs[4 * lane + 1] = bfhi(w2.x); qs[4 * lane + 2] = bflo(w2.y); qs[4 * lane + 3] = bfhi(w2.y); }
        float w[8];
        { const uint4 wv = *(const uint4*)(Y1 + (size_t)row * N1 + Y1_WIDX);
          w[0] = bflo(wv.x); w[1] = bfhi(wv.x); w[2] = bflo(wv.y); w[3] = bfhi(wv.y); w[4] = bflo(wv.z); w[5] = bfhi(wv.z); w[6] = bflo(wv.w); w[7] = bfhi(wv.w); }
        LDS_WAIT(); asm volatile("" ::: "memory");
        const int nw = (q >> 6) + 1;
        unsigned long long mine = 0ull;
        if (q + 1 <= TOPK) {
#pragma unroll
            for (int i = 0; i < 32; ++i) { const unsigned long long word = __ballot(64 * i + lane <= q); mine = (lane == i) ? word : mine; }
        } else {
            for (int i = 0; i < nw; ++i) {
                const int key = 64 * i + lane; float s = -INFINITY;
                if (key <= q) {
                    const uint4* kp = (const uint4*)(Y1 + (size_t)(b * SEQ + key) * N1 + Y1_KIDX);
                    float k[32];
#pragma unroll
                    for (int j = 0; j < 4; ++j) { const uint4 kv = kp[j];
                        k[8 * j + 0] = bflo(kv.x); k[8 * j + 1] = bfhi(kv.x); k[8 * j + 2] = bflo(kv.y); k[8 * j + 3] = bfhi(kv.y);
                        k[8 * j + 4] = bflo(kv.z); k[8 * j + 5] = bfhi(kv.z); k[8 * j + 6] = bflo(kv.w); k[8 * j + 7] = bfhi(kv.w); }
                    float acc = 0.0f;
#pragma unroll
                    for (int h = 0; h < 8; ++h) { float d = 0.0f;
#pragma unroll
                        for (int t = 0; t < 32; ++t) d += k[t] * qs[h * 32 + t];
                        acc += w[h] * fmaxf(d, 0.0f); }
                    s = acc + 0.0f;
                }
                sc[key] = s;
            }
            LDS_WAIT(); asm volatile("" ::: "memory");
            unsigned keyv[32];
#pragma unroll
            for (int i = 0; i < 32; ++i) { const float v = (i < nw) ? sc[64 * i + lane] : -INFINITY; keyv[i] = sort_key(v); }
            mine = topk_select(keyv, lane);
        }
        if (lane < 32) MASK[(size_t)row * 32 + lane] = mine;
        LDS_WAIT(); asm volatile("" ::: "memory");
    }
}

__device__ __forceinline__ void diffattn_naive(Frame& F, const Ptrs& P, const bf16* Y1, bf16* YC) {
    const int gw = F.vcu * NWAVES + F.wave, NGW = F.G * NWAVES, lane = F.lane, l5 = lane & 31;
    const float lam = __expf(wave_sum(P.in[11][lane] * P.in[12][lane])) - __expf(wave_sum(P.in[13][lane] * P.in[14][lane])) + LAM_INIT;
    const float* subg = P.in[15];
    for (int task = gw; task < M * 4; task += NGW) {
        const int row = task >> 2, h = task & 3, b = row >> 11, q = row & 2047;
        const unsigned qv = *(const unsigned*)(Y1 + (size_t)row * N1 + Y1_QA + 128 * h + 2 * lane);
        const float q0 = bflo(qv), q1 = bfhi(qv);
        const float slope2 = exp2f(-2.0f * (float)(h + 1)) * LOG2E;
        float m = -1e30f, l = 0.0f, o[4] = {0.f, 0.f, 0.f, 0.f};
        const bf16* Kb = Y1 + (size_t)(b * SEQ) * N1 + Y1_KA + 128 * h + 2 * lane;
        const bf16* Vb = Y1 + (size_t)(b * SEQ) * N1 + Y1_VA + 128 * h + 4 * l5;
        for (int k0 = 0; k0 <= q; k0 += 4) {
            unsigned kk[4]; uint2 vv[4];
#pragma unroll
            for (int j = 0; j < 4; ++j) { const int k = min(k0 + j, q); kk[j] = *(const unsigned*)(Kb + (size_t)k * N1); vv[j] = *(const uint2*)(Vb + (size_t)k * N1); }
#pragma unroll
            for (int j = 0; j < 4; ++j) {
                const int k = k0 + j;
                float part = q0 * bflo(kk[j]) + q1 * bfhi(kk[j]);
                part += __shfl_xor(part, 1); part += __shfl_xor(part, 2); part += __shfl_xor(part, 4); part += __shfl_xor(part, 8); part += __shfl_xor(part, 16);
                if (k <= q) {
                    const float s = part - slope2 * (float)(q - k);
                    const float mn = fmaxf(m, s), alpha = exp2f(m - mn), p = exp2f(s - mn);
                    l = l * alpha + p;
                    o[0] = o[0] * alpha + p * bflo(vv[j].x); o[1] = o[1] * alpha + p * bfhi(vv[j].x); o[2] = o[2] * alpha + p * bflo(vv[j].y); o[3] = o[3] * alpha + p * bfhi(vv[j].y);
                    m = mn;
                }
            }
        }
        const float il = 1.0f / l;
        float d[4]; float ss = 0.0f;
#pragma unroll
        for (int i = 0; i < 4; ++i) { const float mine = o[i] * il, other = __shfl_xor(mine, 32); d[i] = mine - lam * other; ss += d[i] * d[i]; }
        ss += __shfl_xor(ss, 1); ss += __shfl_xor(ss, 2); ss += __shfl_xor(ss, 4); ss += __shfl_xor(ss, 8); ss += __shfl_xor(ss, 16);
        const float rs = 1.0f / sqrtf(ss * (1.0f / 128.0f) + EPS) * (1.0f - LAM_INIT);
        if (lane < 32) {
            const uint2 gv = *(const uint2*)(Y1 + (size_t)row * N1 + Y1_GATE + 128 * h + 4 * l5);
            const float g0 = bflo(gv.x), g1 = bfhi(gv.x), g2 = bflo(gv.y), g3 = bfhi(gv.y);
            const float y0 = d[0] * rs * subg[4 * l5 + 0] * silu_f(g0), y1 = d[1] * rs * subg[4 * l5 + 1] * silu_f(g1), y2 = d[2] * rs * subg[4 * l5 + 2] * silu_f(g2), y3 = d[3] * rs * subg[4 * l5 + 3] * silu_f(g3);
            *(uint2*)(YC + (size_t)row * DM + 128 * h + 4 * l5) = make_uint2(pk2(y0, y1), pk2(y2, y3));
        }
    }
}

__device__ __forceinline__ void dsa_naive(Frame& F, const bf16* Y1, const bf16* QL, const unsigned long long* MASK, bf16* YC) {
    const int gw = F.vcu * NWAVES + F.wave, NGW = F.G * NWAVES, lane = F.lane, h = lane >> 3, j = lane & 7;
    const float slope2 = exp2f(-(float)(h + 1)) * LOG2E;
    for (int row = gw; row < M; row += NGW) {
        const int b = row >> 11, q = row & 2047;
        float qf[16];
        { const uint4* qp = (const uint4*)(QL + (size_t)row * N2 + 128 * h + 16 * j);
#pragma unroll
          for (int t = 0; t < 2; ++t) { const uint4 v = qp[t]; qf[8 * t + 0] = bflo(v.x); qf[8 * t + 1] = bfhi(v.x); qf[8 * t + 2] = bflo(v.y); qf[8 * t + 3] = bfhi(v.y); qf[8 * t + 4] = bflo(v.z); qf[8 * t + 5] = bfhi(v.z); qf[8 * t + 6] = bflo(v.w); qf[8 * t + 7] = bfhi(v.w); } }
        float m = -1e30f, l = 0.0f, o[8];
#pragma unroll
        for (int i = 0; i < 8; ++i) o[i] = 0.0f;
        const int nw = (q >> 6) + 1;
        for (int t = 0; t < nw; ++t) {
            const unsigned long long wraw = MASK[(size_t)row * 32 + t];
            unsigned long long w = ((unsigned long long)(unsigned)__builtin_amdgcn_readfirstlane((int)(wraw >> 32)) << 32) | (unsigned)__builtin_amdgcn_readfirstlane((int)(unsigned)wraw);
            while (w) {
                const int bit = __builtin_ctzll(w); w &= w - 1ull;
                const int k = 64 * t + bit; const bf16* kr = QL + (size_t)(b * SEQ + k) * N2;
                const uint4 ka = *(const uint4*)(kr + QL_KV + 16 * j), kb = *(const uint4*)(kr + QL_KV + 16 * j + 8);
                const uint4 vp = *(const uint4*)(kr + QL_VP + 64 * h + 8 * j);
                float part = qf[0] * bflo(ka.x) + qf[1] * bfhi(ka.x) + qf[2] * bflo(ka.y) + qf[3] * bfhi(ka.y) + qf[4] * bflo(ka.z) + qf[5] * bfhi(ka.z) + qf[6] * bflo(ka.w) + qf[7] * bfhi(ka.w)
                           + qf[8] * bflo(kb.x) + qf[9] * bfhi(kb.x) + qf[10] * bflo(kb.y) + qf[11] * bfhi(kb.y) + qf[12] * bflo(kb.z) + qf[13] * bfhi(kb.z) + qf[14] * bflo(kb.w) + qf[15] * bfhi(kb.w);
                part += __shfl_xor(part, 1); part += __shfl_xor(part, 2); part += __shfl_xor(part, 4);
                const float s = part - slope2 * (float)(q - k);
                const float mn = fmaxf(m, s), alpha = exp2f(m - mn), p = exp2f(s - mn);
                l = l * alpha + p; m = mn;
                o[0] = o[0] * alpha + p * bflo(vp.x); o[1] = o[1] * alpha + p * bfhi(vp.x); o[2] = o[2] * alpha + p * bflo(vp.y); o[3] = o[3] * alpha + p * bfhi(vp.y);
                o[4] = o[4] * alpha + p * bflo(vp.z); o[5] = o[5] * alpha + p * bfhi(vp.z); o[6] = o[6] * alpha + p * bflo(vp.w); o[7] = o[7] * alpha + p * bfhi(vp.w);
            }
        }
        const float il = 1.0f / l;
        const uint4 gv = *(const uint4*)(Y1 + (size_t)row * N1 + Y1_GATE + 512 + 64 * h + 8 * j);
        const float g[8] = {bflo(gv.x), bfhi(gv.x), bflo(gv.y), bfhi(gv.y), bflo(gv.z), bfhi(gv.z), bflo(gv.w), bfhi(gv.w)};
        float y[8];
#pragma unroll
        for (int i = 0; i < 8; ++i) y[i] = o[i] * il * silu_f(g[i]);
        *(uint4*)(YC + (size_t)row * DM + 512 + 64 * h + 8 * j) = make_uint4(pk2(y[0], y[1]), pk2(y[2], y[3]), pk2(y[4], y[5]), pk2(y[6], y[7]));
    }
}

__device__ __forceinline__ void swa_naive(Frame& F, const Ptrs& P, const bf16* Y2, bf16* YC) {
    const int gw = F.vcu * NWAVES + F.wave, NGW = F.G * NWAVES, lane = F.lane;
    LAS float* qs = (LAS float*)(F.lds + RING_OFF + F.wave * 1024);
    const float* sinks = P.in[18];
    for (int task = gw; task < M * 8; task += NGW) {
        const int row = task >> 3, head = task & 7, g = head >> 2, b = row >> 11, q = row & 2047;
        qs[lane] = bf2f(Y2[(size_t)row * N3 + 64 * head + lane]);
        LDS_WAIT(); asm volatile("" ::: "memory");
        const float slope2 = exp2f(-(float)(head + 1)) * LOG2E, sink2 = sinks[head] * LOG2E;
        float s2[2];
#pragma unroll
        for (int ds = 0; ds < 2; ++ds) {
            const int dist = lane + 64 * ds, k = q - dist; float s = -INFINITY;
            if (k >= 0) {
                const uint4* kp = (const uint4*)(Y2 + (size_t)(b * SEQ + k) * N3 + Y2_KC + 64 * g);
                float dot = 0.0f;
#pragma unroll
                for (int t = 0; t < 8; ++t) { const uint4 kv = kp[t];
                    dot += qs[8 * t + 0] * bflo(kv.x) + qs[8 * t + 1] * bfhi(kv.x) + qs[8 * t + 2] * bflo(kv.y) + qs[8 * t + 3] * bfhi(kv.y)
                         + qs[8 * t + 4] * bflo(kv.z) + qs[8 * t + 5] * bfhi(kv.z) + qs[8 * t + 6] * bflo(kv.w) + qs[8 * t + 7] * bfhi(kv.w); }
                s = dot - slope2 * (float)dist;
            }
            s2[ds] = s;
        }
        const float m = fmaxf(wave_max(fmaxf(s2[0], s2[1])), sink2);
        const float p0 = exp2f(s2[0] - m), p1 = exp2f(s2[1] - m);
        const float denom = wave_sum(p0 + p1) + exp2f(sink2 - m);
        float acc = 0.0f;
        const int nd = min(127, q);
        const bf16* vb = Y2 + (size_t)(b * SEQ) * N3 + Y2_VC + 64 * g + lane;
        for (int dist = 0; dist <= nd; ++dist) {
            const float p = (dist < 64) ? __shfl(p0, dist) : __shfl(p1, dist - 64);
            acc += p * bf2f(vb[(size_t)(q - dist) * N3]);
        }
        const float gt = bf2f(Y2[(size_t)row * N3 + Y2_GATE + 64 * head + lane]);
        YC[(size_t)row * DM + 64 * head + lane] = (bf16)f2bf(acc / denom * silu_f(gt));
        LDS_WAIT(); asm volatile("" ::: "memory");
    }
}

__device__ __forceinline__ void conv_phase(Frame& F, const Ptrs& P, const bf16* Y2, bf16* YC) {
    LAS float* CO = (LAS float*)(F.lds + RING_OFF);
    const float* dww = P.in[19]; const float* dwb = P.in[20]; const float* lng = P.in[21]; const float* lnb = P.in[22];
    const int c = F.tid;
    float wt[31];
#pragma unroll
    for (int j = 0; j < 31; ++j) wt[j] = dww[j * 512 + c];
    const float bias = dwb[c];
    for (int u = F.vcu; u < BATCH * 64; u += F.G) {
        const int b = u >> 6, t0 = (u & 63) * 32;
        float h[62];
#pragma unroll
        for (int r = 0; r < 62; ++r) { const int pos = t0 - 30 + r; float v = 0.0f;
            if (pos >= 0) { const bf16* rp = Y2 + (size_t)(b * SEQ + pos) * N3; const float val = bf2f(rp[Y2_DVAL + c]), gt = bf2f(rp[Y2_DGATE + c]); v = val / (1.0f + __expf(-gt)); }
            h[r] = v; }
#pragma unroll
        for (int t = 0; t < 32; ++t) { float a = bias;
#pragma unroll
            for (int j = 0; j < 31; ++j) a += wt[j] * h[t + j];
            CO[t * 512 + c] = a; }
        __syncthreads();
#pragma unroll
        for (int tt = 0; tt < 4; ++tt) { const int t = F.wave * 4 + tt, row = b * SEQ + t0 + t;
            float v[8]; float s = 0.0f;
#pragma unroll
            for (int i = 0; i < 8; ++i) { v[i] = CO[t * 512 + F.lane + 64 * i]; s += v[i]; }
            const float mu = wave_sum(s) * (1.0f / 512.0f); float s2 = 0.0f;
#pragma unroll
            for (int i = 0; i < 8; ++i) { v[i] -= mu; s2 += v[i] * v[i]; }
            const float rstd = 1.0f / sqrtf(wave_sum(s2) * (1.0f / 512.0f) + EPS);
#pragma unroll
            for (int i = 0; i < 8; ++i) { const int ch = F.lane + 64 * i; const float y = v[i] * rstd * lng[ch] + lnb[ch];
                const float gt = bf2f(Y2[(size_t)row * N3 + Y2_GATE + 512 + ch]);
                YC[(size_t)row * DM + 512 + ch] = (bf16)f2bf(silu_f(y) * silu_f(gt)); } }
        __syncthreads();
    }
}

namespace fa {
typedef short bf16x8 __attribute__((ext_vector_type(8)));
typedef short s16x4 __attribute__((ext_vector_type(4)));
typedef float f32x16 __attribute__((ext_vector_type(16)));
typedef float f32x4 __attribute__((ext_vector_type(4)));
constexpr int BUF_BYTES = 32768, V_OFF = 16384, SCR_OFF = 65536;
constexpr float THR = 6.0f;
__device__ __forceinline__ unsigned offb(unsigned row, unsigned ch) { return 256u * row + 16u * (ch ^ (((row & 3u) << 2) | ((row >> 2) & 3u))); }
__device__ __forceinline__ constexpr int cr(int r) { return (r & 3) + 8 * (r >> 2); }
__device__ __forceinline__ unsigned cvtpk(float lo, float hi) { typedef float f2 __attribute__((ext_vector_type(2))); typedef __bf16 b2 __attribute__((ext_vector_type(2))); f2 v = {lo, hi}; b2 b = __builtin_convertvector(v, b2); return __builtin_bit_cast(unsigned, b); }
typedef short v4i16_t __attribute__((ext_vector_type(4)));
__device__ __forceinline__ s16x4 vtr(const LAS unsigned char* p) { return __builtin_bit_cast(s16x4, __builtin_amdgcn_ds_read_tr16_b64_v4i16((LAS v4i16_t*)p)); }

struct Epi {
    const bf16* gate; int gpitch;
    bf16* out;
    float lam; const float* subg;
};

template <int MODE> __device__ __forceinline__ void attn_unit(LAS unsigned char* lds, const bf16* Qw, int qp, const bf16* Kt, const bf16* Vt, int kvp,
                                                              int kc0, int vb0, int qw, int t_lo, int t_hi, float slope2, const unsigned long long* maskw, float sink2, const Epi& E) {
    constexpr int DQK = (MODE == 1) ? 128 : 64, DV = (MODE == 0) ? 128 : 64, NS = DQK / 16, NB = DV / 32;
    const int tid = threadIdx.x, lane = tid & 63, r32 = lane & 31, hi = lane >> 5, wid = __builtin_amdgcn_readfirstlane(tid >> 6);
    const int q = qw + r32;
    LAS float* scr = (LAS float*)(lds + SCR_OFF + wid * 128);
    const int srow0 = tid >> 4, sch = tid & 15;
    const unsigned sw0 = offb(srow0, sch), sw1 = offb(srow0 + 32, sch);
    const bf16* gk = Kt + (size_t)srow0 * kvp + 8 * sch; const bf16* gv = Vt + (size_t)srow0 * kvp + 8 * sch;
    v4u sk0, sk1, sv0, sv1;
#define FA_LOAD(t) do { const size_t o_ = (size_t)(t) * 64 * kvp; sk0 = *(const v4u*)(gk + o_); sk1 = *(const v4u*)(gk + o_ + (size_t)32 * kvp); sv0 = *(const v4u*)(gv + o_); sv1 = *(const v4u*)(gv + o_ + (size_t)32 * kvp); } while (0)
#define FA_WRITE(b) do { LAS unsigned char* p_ = lds + (b) * BUF_BYTES; *(LAS v4u*)(p_ + sw0) = sk0; *(LAS v4u*)(p_ + sw1) = sk1; *(LAS v4u*)(p_ + V_OFF + sw0) = sv0; *(LAS v4u*)(p_ + V_OFF + sw1) = sv1; } while (0)
    const unsigned xl = ((((unsigned)r32 & 3u) << 2) | (((unsigned)r32 >> 2) & 3u)) ^ (unsigned)hi;
    const unsigned krow = 256u * (unsigned)r32;
    const unsigned blk = (lane >> 4) & 1, qq = (lane & 15) >> 2, pp = lane & 3;
    unsigned VA[2][NB];
#pragma unroll
    for (int t = 0; t < 2; ++t)
#pragma unroll
        for (int c = 0; c < NB; ++c) VA[t][c] = V_OFF + 256u * (4u * hi + qq) + 8u * (pp & 1u) + 16u * ((((2u * blk + (pp >> 1)) ^ (unsigned)hi)) ^ (2u * t)) + 64u * ((((unsigned)(vb0 + c)) ^ qq) & 3u) + 2048u * t;
    bf16x8 qf[NS];
#pragma unroll
    for (int s = 0; s < NS; ++s) qf[s] = *(const bf16x8*)(Qw + (size_t)r32 * qp + 16 * s + 8 * hi);
    f32x16 o[NB];
#pragma unroll
    for (int c = 0; c < NB; ++c)
#pragma unroll
        for (int r = 0; r < 16; ++r) o[c][r] = 0.0f;
    float m = -1e30f, l = 0.0f;
    unsigned long long mw_next = 0ull;
    if (MODE == 1) mw_next = maskw[(size_t)r32 * 32 + t_lo];

    FA_LOAD(t_lo); FA_WRITE(0); __syncthreads();
    for (int t = t_lo; t < t_hi; ++t) {
        const int cur = (t - t_lo) & 1;
        const bool more = (t + 1 < t_hi);
        if (more) FA_LOAD(t + 1);
        unsigned long long mw = mw_next;
        if (MODE == 1 && more) mw_next = maskw[(size_t)r32 * 32 + t + 1];
        bool active = (64 * t <= qw + 31);
        if (MODE == 2) active = active && (64 * t + 63 >= qw - 127);
        if (active) {
            const LAS unsigned char* kb = lds + cur * BUF_BYTES;
            f32x16 p0, p1;
            { const float d0 = slope2 * (float)(64 * t - q + 4 * hi);
#pragma unroll
              for (int r = 0; r < 16; ++r) { p0[r] = __builtin_fmaf(slope2, (float)cr(r), d0); p1[r] = __builtin_fmaf(slope2, (float)(cr(r) + 32), d0); } }
#pragma unroll
            for (int s = 0; s < NS; ++s) {
                const unsigned ko = krow + 16u * (((unsigned)(kc0 + 2 * s)) ^ xl);
                const bf16x8 a0 = *(const LAS bf16x8*)(kb + ko), a1 = *(const LAS bf16x8*)(kb + ko + 8192u);
                p0 = __builtin_amdgcn_mfma_f32_32x32x16_bf16(a0, qf[s], p0, 0, 0, 0);
                p1 = __builtin_amdgcn_mfma_f32_32x32x16_bf16(a1, qf[s], p1, 0, 0, 0);
            }
            if (MODE == 0) {
                if (64 * t + 63 > qw) { const int qd = q - 64 * t - 4 * hi;
#pragma unroll
                    for (int r = 0; r < 16; ++r) { if (cr(r) > qd) p0[r] = -INFINITY; if (cr(r) + 32 > qd) p1[r] = -INFINITY; } }
            } else if (MODE == 2) {
                const int qd = q - 64 * t - 4 * hi;
#pragma unroll
                for (int r = 0; r < 16; ++r) { const int d0_ = qd - cr(r), d1_ = d0_ - 32; if (d0_ < 0 || d0_ > 127) p0[r] = -INFINITY; if (d1_ < 0 || d1_ > 127) p1[r] = -INFINITY; }
            } else {
                const int wl = (int)((unsigned)mw >> (4 * hi)), wh = (int)((unsigned)(mw >> 32) >> (4 * hi));
#pragma unroll
                for (int r = 0; r < 16; ++r) {
                    const int m0 = __builtin_amdgcn_sbfe(wl, cr(r), 1), m1 = __builtin_amdgcn_sbfe(wh, cr(r), 1);
                    p0[r] = __int_as_float((__float_as_int(p0[r]) & m0) | (~m0 & (int)0xff800000));
                    p1[r] = __int_as_float((__float_as_int(p1[r]) & m1) | (~m1 & (int)0xff800000));
                }
            }
            float rm = fmaxf(p0[0], p1[0]);
#pragma unroll
            for (int r = 1; r < 16; ++r) rm = fmaxf(rm, fmaxf(p0[r], p1[r]));
            { auto rr = __builtin_amdgcn_permlane32_swap(__float_as_uint(rm), __float_as_uint(rm), false, false); rm = fmaxf(__uint_as_float(rr[0]), __uint_as_float(rr[1])); }
            if (__any(rm > m + THR)) {
                const float mn = fmaxf(m, rm), f = __builtin_amdgcn_exp2f(m - mn); m = mn; l *= f;
                if (hi == 0) scr[r32] = f;
                asm volatile("s_waitcnt lgkmcnt(0)" ::: "memory");
#pragma unroll
                for (int g = 0; g < 4; ++g) { const f32x4 fv = *(const LAS f32x4*)(scr + 8 * g + 4 * hi);
#pragma unroll
                    for (int c = 0; c < NB; ++c) { o[c][4 * g + 0] *= fv[0]; o[c][4 * g + 1] *= fv[1]; o[c][4 * g + 2] *= fv[2]; o[c][4 * g + 3] *= fv[3]; } }
            }
            float ls = 0.0f;
#pragma unroll
            for (int r = 0; r < 16; ++r) { p0[r] = __builtin_amdgcn_exp2f(p0[r] - m); p1[r] = __builtin_amdgcn_exp2f(p1[r] - m); ls += p0[r] + p1[r]; }
            l += ls;
            bf16x8 pa[4];
#pragma unroll
            for (int s = 0; s < 2; ++s) {
                const unsigned a0 = cvtpk(p0[8 * s + 0], p0[8 * s + 1]), a1 = cvtpk(p0[8 * s + 2], p0[8 * s + 3]), a2 = cvtpk(p0[8 * s + 4], p0[8 * s + 5]), a3 = cvtpk(p0[8 * s + 6], p0[8 * s + 7]);
                const unsigned b0 = cvtpk(p1[8 * s + 0], p1[8 * s + 1]), b1 = cvtpk(p1[8 * s + 2], p1[8 * s + 3]), b2 = cvtpk(p1[8 * s + 4], p1[8 * s + 5]), b3 = cvtpk(p1[8 * s + 6], p1[8 * s + 7]);
                pa[s] = __builtin_bit_cast(bf16x8, (v4u){a0, a1, a2, a3}); pa[2 + s] = __builtin_bit_cast(bf16x8, (v4u){b0, b1, b2, b3});
            }
#pragma unroll
            for (int c = 0; c < NB; ++c)
#pragma unroll
                for (int ks = 0; ks < 4; ++ks) {
                    const s16x4 v0 = vtr(kb + VA[0][c] + 4096u * ks), v1 = vtr(kb + VA[1][c] + 4096u * ks);
                    const bf16x8 vf = (bf16x8){v0[0], v0[1], v0[2], v0[3], v1[0], v1[1], v1[2], v1[3]};
                    o[c] = __builtin_amdgcn_mfma_f32_32x32x16_bf16(pa[ks], vf, o[c], 0, 0, 0);
                }
        }
        if (more) FA_WRITE(cur ^ 1);
        __syncthreads();
    }
#undef FA_LOAD
#undef FA_WRITE
    { auto rr = __builtin_amdgcn_permlane32_swap(__float_as_uint(l), __float_as_uint(l), false, false); l = __uint_as_float(rr[0]) + __uint_as_float(rr[1]); }
    if (MODE == 2) l += exp2f(sink2 - m);
    float il = 1.0f / l;
    if (MODE == 0 && wid >= 4) il *= E.lam;
    if (hi == 0) scr[r32] = il;
    asm volatile("s_waitcnt lgkmcnt(0)" ::: "memory");
    float ilr[16];
#pragma unroll
    for (int g = 0; g < 4; ++g) { const f32x4 fv = *(const LAS f32x4*)(scr + 8 * g + 4 * hi); ilr[4 * g + 0] = fv[0]; ilr[4 * g + 1] = fv[1]; ilr[4 * g + 2] = fv[2]; ilr[4 * g + 3] = fv[3]; }
    if (MODE == 0) {
        LAS float* X = (LAS float*)(lds + (wid & 3) * 16384);
        if (wid >= 4) {
#pragma unroll
            for (int c = 0; c < NB; ++c)
#pragma unroll
                for (int r = 0; r < 16; ++r) X[(cr(r) + 4 * hi) * 128 + 32 * c + r32] = o[c][r] * ilr[r];
        }
        __syncthreads();
        if (wid < 4) {
#pragma unroll
            for (int c = 0; c < NB; ++c)
#pragma unroll
                for (int r = 0; r < 16; ++r) { LAS float* xp = X + (cr(r) + 4 * hi) * 128 + 32 * c + r32; *xp = o[c][r] * ilr[r] - *xp; }
            asm volatile("s_waitcnt lgkmcnt(0)" ::: "memory");
#pragma unroll
            for (int i = 0; i < 8; ++i) { const int id = lane + 64 * i, row = id >> 4, ch = id & 15;
                const f32x4 v0 = *(const LAS f32x4*)(X + row * 128 + 8 * ch), v1 = *(const LAS f32x4*)(X + row * 128 + 8 * ch + 4);
                float ss = (v0[0] * v0[0] + v0[1] * v0[1]) + (v0[2] * v0[2] + v0[3] * v0[3]) + (v1[0] * v1[0] + v1[1] * v1[1]) + (v1[2] * v1[2] + v1[3] * v1[3]);
                ss += __shfl_xor(ss, 1); ss += __shfl_xor(ss, 2); ss += __shfl_xor(ss, 4); ss += __shfl_xor(ss, 8);
                const float rs = 1.0f / sqrtf(ss * (1.0f / 128.0f) + EPS) * (1.0f - LAM_INIT);
                const uint4 gv = *(const uint4*)(E.gate + (size_t)row * E.gpitch + 8 * ch);
                const f32x4 s0 = *(const f32x4*)(E.subg + 8 * ch), s1 = *(const f32x4*)(E.subg + 8 * ch + 4);
                const float y0 = v0[0] * rs * s0[0] * silu_f(bflo(gv.x)), y1 = v0[1] * rs * s0[1] * silu_f(bfhi(gv.x)), y2 = v0[2] * rs * s0[2] * silu_f(bflo(gv.y)), y3 = v0[3] * rs * s0[3] * silu_f(bfhi(gv.y));
                const float y4 = v1[0] * rs * s1[0] * silu_f(bflo(gv.z)), y5 = v1[1] * rs * s1[1] * silu_f(bfhi(gv.z)), y6 = v1[2] * rs * s1[2] * silu_f(bflo(gv.w)), y7 = v1[3] * rs * s1[3] * silu_f(bfhi(gv.w));
                *(uint4*)(E.out + (size_t)row * 1024 + 8 * ch) = make_uint4(cvtpk(y0, y1), cvtpk(y2, y3), cvtpk(y4, y5), cvtpk(y6, y7)); }
        }
        __syncthreads();
    } else {
        LAS float* X = (LAS float*)(lds + wid * 8192);
#pragma unroll
        for (int c = 0; c < NB; ++c)
#pragma unroll
            for (int r = 0; r < 16; ++r) X[(cr(r) + 4 * hi) * 64 + 32 * c + r32] = o[c][r] * ilr[r];
        asm volatile("s_waitcnt lgkmcnt(0)" ::: "memory");
#pragma unroll
        for (int i = 0; i < 4; ++i) { const int id = lane + 64 * i, row = id >> 3, ch = id & 7;
            const f32x4 v0 = *(const LAS f32x4*)(X + row * 64 + 8 * ch), v1 = *(const LAS f32x4*)(X + row * 64 + 8 * ch + 4);
            const uint4 gv = *(const uint4*)(E.gate + (size_t)row * E.gpitch + 8 * ch);
            const float y0 = v0[0] * silu_f(bflo(gv.x)), y1 = v0[1] * silu_f(bfhi(gv.x)), y2 = v0[2] * silu_f(bflo(gv.y)), y3 = v0[3] * silu_f(bfhi(gv.y));
            const float y4 = v1[0] * silu_f(bflo(gv.z)), y5 = v1[1] * silu_f(bfhi(gv.z)), y6 = v1[2] * silu_f(bflo(gv.w)), y7 = v1[3] * silu_f(bfhi(gv.w));
            *(uint4*)(E.out + (size_t)row * 1024 + 8 * ch) = make_uint4(cvtpk(y0, y1), cvtpk(y2, y3), cvtpk(y4, y5), cvtpk(y6, y7)); }
        __syncthreads();
    }
}
}

__device__ __forceinline__ void attn_phase_a(Frame& F, const Ptrs& P, const bf16* Y1, bf16* YC) {
    const int w = F.wave, qg = w & 3, role = w >> 2;
    const float lam = __expf(wave_sum(P.in[11][F.lane] * P.in[12][F.lane])) - __expf(wave_sum(P.in[13][F.lane] * P.in[14][F.lane])) + LAM_INIT;
    for (int v = F.vcu; v < 256; v += F.G) {
        const int bh = v >> 3, s = v & 7, b = bh >> 2, h = bh & 3; const size_t r0 = (size_t)b * SEQ;
        for (int i = 0; i < 2; ++i) {
            const int qb = i == 0 ? s : 15 - s, q0 = 128 * qb, qw = q0 + 32 * qg;
            fa::Epi E; E.gate = Y1 + (r0 + qw) * N1 + Y1_GATE + 128 * h; E.gpitch = N1; E.out = YC + (r0 + qw) * DM + 128 * h; E.lam = lam; E.subg = P.in[15];
            fa::attn_unit<0>(F.lds + RING_OFF, Y1 + (r0 + qw) * N1 + Y1_QA + 128 * h + 64 * role, N1, Y1 + r0 * N1 + Y1_KA + 128 * h, Y1 + r0 * N1 + Y1_VA + 128 * h, N1,
                             8 * role, 0, qw, 0, 2 * qb + 2, exp2f(-2.0f * (float)(h + 1)) * LOG2E, nullptr, 0.0f, E);
        }
    }
}
__device__ __forceinline__ void attn_phase_b(Frame& F, const bf16* Y1, const bf16* QL, const unsigned long long* MASK, bf16* YC) {
    const int w = F.wave, qg = w & 3, role = w >> 2;
    for (int v = F.vcu; v < 256; v += F.G) {
        const int bh = v >> 3, s = v & 7, b = bh >> 2, hp = bh & 3, head = 2 * hp + role; const size_t r0 = (size_t)b * SEQ;
        for (int i = 0; i < 2; ++i) {
            const int qb = i == 0 ? s : 15 - s, q0 = 128 * qb, qw = q0 + 32 * qg;
            fa::Epi E; E.gate = Y1 + (r0 + qw) * N1 + Y1_GATE + 512 + 64 * head; E.gpitch = N1; E.out = YC + (r0 + qw) * DM + 512 + 64 * head; E.lam = 0.f; E.subg = nullptr;
            fa::attn_unit<1>(F.lds + RING_OFF, QL + (r0 + qw) * N2 + 128 * head, N2, QL + r0 * N2 + QL_KV, QL + r0 * N2 + QL_VP + 128 * hp, N2,
                             0, 2 * role, qw, 0, 2 * qb + 2, exp2f(-(float)(head + 1)) * LOG2E, MASK + (r0 + qw) * 32, 0.0f, E);
        }
    }
}
__device__ __forceinline__ void attn_phase_c(Frame& F, const Ptrs& P, const bf16* Y2, bf16* YC) {
    const int w = F.wave, qg = w & 3, g = w >> 2;
    for (int u = F.vcu; u < 512; u += F.G) {
        const int b = u >> 6, n = (u >> 2) & 15, r = u & 3, head = 4 * g + r, q0 = 128 * n, qw = q0 + 32 * qg; const size_t r0 = (size_t)b * SEQ;
        fa::Epi E; E.gate = Y2 + (r0 + qw) * N3 + Y2_GATE + 64 * head; E.gpitch = N3; E.out = YC + (r0 + qw) * DM + 64 * head; E.lam = 0.f; E.subg = nullptr;
        const int t_lo = (n == 0) ? 0 : 2 * n - 2, t_hi = 2 * n + 2;
        fa::attn_unit<2>(F.lds + RING_OFF, Y2 + (r0 + qw) * N3 + 64 * head, N3, Y2 + r0 * N3 + Y2_KC, Y2 + r0 * N3 + Y2_VC, N3,
                         8 * g, 2 * g, qw, t_lo, t_hi, exp2f(-(float)(head + 1)) * LOG2E, nullptr, P.in[18][head] * LOG2E, E);
    }
}

__device__ __forceinline__ unsigned long long topk_select_nw(const unsigned (&keyv)[32], int lane, int nw) {
    unsigned T = 0u; bool exact = false;
    for (int bit = 31; bit >= 0; --bit) {
        const unsigned cand = T | (1u << bit); int cnt = 0;
#pragma unroll
        for (int i = 0; i < 32; ++i) if (i < nw) cnt += __popcll(__ballot(keyv[i] >= cand));
        if (cnt >= TOPK) { T = cand; if (cnt == TOPK) { exact = true; break; } }
    }
    unsigned long long mine = 0ull;
    if (exact) {
#pragma unroll
        for (int i = 0; i < 32; ++i) if (i < nw) { const unsigned long long word = __ballot(keyv[i] >= T); mine = (lane == i) ? word : mine; }
        return mine;
    }
    int cgt = 0;
#pragma unroll
    for (int i = 0; i < 32; ++i) if (i < nw) cgt += __popcll(__ballot(keyv[i] > T));
    int need = TOPK - cgt;
#pragma unroll
    for (int i = 0; i < 32; ++i) if (i < nw) {
        const unsigned long long g = __ballot(keyv[i] > T), e = __ballot(keyv[i] == T);
        const int ne = __popcll(e);
        unsigned long long take;
        if (ne <= need) { take = e; need -= ne; } else { take = lowest_n_bits(e, need); need = 0; }
        const unsigned long long word = g | take;
        mine = (lane == i) ? word : mine;
    }
    return mine;
}
__device__ __forceinline__ void indexer_fast(Frame& F, const bf16* Y1, const bf16* QL, unsigned long long* MASK) {
    typedef short bf16x8v __attribute__((ext_vector_type(8)));
    const int lane = F.lane, w = F.wave, l15 = lane & 15, lg = lane >> 4;
    constexpr int SCP = 2052;
    LAS float* SC = (LAS float*)(F.lds + RING_OFF);
    for (int v = F.vcu; v < 256; v += F.G) {
        const int b = v >> 5, s = v & 31; const size_t r0 = (size_t)b * SEQ;
        for (int it = 0; it < 4; ++it) {
            const int qt = (it == 0) ? s : (it == 1) ? 63 - s : (it == 2) ? 64 + s : 127 - s;
            const int q0 = 16 * qt;
            if (qt >= 16) {
                bf16x8v qf[8];
#pragma unroll
                for (int h = 0; h < 8; ++h) qf[h] = *(const bf16x8v*)(QL + (r0 + q0 + l15) * N2 + QL_QIDX + 32 * h + 8 * lg);
                float wv[8];
                { const uint4 t4 = *(const uint4*)(Y1 + (r0 + q0 + l15) * N1 + Y1_WIDX);
                  wv[0] = bflo(t4.x); wv[1] = bfhi(t4.x); wv[2] = bflo(t4.y); wv[3] = bfhi(t4.y); wv[4] = bflo(t4.z); wv[5] = bfhi(t4.z); wv[6] = bflo(t4.w); wv[7] = bfhi(t4.w); }
                const int nkb = qt + 1;
                for (int kb0 = w; kb0 < nkb; kb0 += 32) {
                    bf16x8v a[4];
#pragma unroll
                    for (int j = 0; j < 4; ++j) { const int kb = kb0 + 8 * j; if (kb < nkb) a[j] = *(const bf16x8v*)(Y1 + (r0 + 16 * kb + l15) * N1 + Y1_KIDX + 8 * lg); }
#pragma unroll
                    for (int j = 0; j < 4; ++j) { const int kb = kb0 + 8 * j;
                        if (kb < nkb) {
                            f32x4 isc = {0.f, 0.f, 0.f, 0.f};
#pragma unroll
                            for (int h = 0; h < 8; ++h) { const f32x4 z = {0.f, 0.f, 0.f, 0.f};
                                const f32x4 d = __builtin_amdgcn_mfma_f32_16x16x32_bf16(a[j], qf[h], z, 0, 0, 0);
                                isc[0] += wv[h] * fmaxf(d[0], 0.f); isc[1] += wv[h] * fmaxf(d[1], 0.f); isc[2] += wv[h] * fmaxf(d[2], 0.f); isc[3] += wv[h] * fmaxf(d[3], 0.f); }
                            isc = isc + 0.0f;
                            if (kb == qt) {
#pragma unroll
                                for (int e = 0; e < 4; ++e) if (4 * lg + e > l15) isc[e] = -INFINITY; }
                            *(LAS f32x4*)(SC + l15 * SCP + 16 * kb + 4 * lg) = isc;
                        } }
                }
            }
            __syncthreads();
#pragma unroll 1
            for (int rr = 0; rr < 2; ++rr) {
                const int row = 2 * w + rr, q = q0 + row, nw = (q >> 6) + 1;
                unsigned long long mine = 0ull;
                if (q + 1 <= TOPK) {
#pragma unroll
                    for (int i = 0; i < 32; ++i) { const unsigned long long word = __ballot(64 * i + lane <= q); mine = (lane == i) ? word : mine; }
                } else {
                    unsigned keyv[32];
#pragma unroll
                    for (int i = 0; i < 32; ++i) { float vv = -INFINITY; if (i < nw) { const float t = SC[row * SCP + 64 * i + lane]; vv = (64 * i + lane <= q) ? t : -INFINITY; } keyv[i] = sort_key(vv); }
                    mine = topk_select_nw(keyv, lane, nw);
                }
                if (lane < 32) MASK[(r0 + q) * 32 + lane] = mine;
            }
            __syncthreads();
        }
    }
}

#ifndef FAST_I
#define FAST_I 1
#endif
#ifndef FAST_A
#define FAST_A 1
#endif
#ifndef FAST_B
#define FAST_B 1
#endif
#ifndef FAST_C
#define FAST_C 1
#endif
#ifndef MK_PER_PHASE
#define MK_PER_PHASE 0
#endif
constexpr int N_PHASES = 12;
struct Args { const float* in[25]; float* out; unsigned char* ws; int ph_lo, ph_hi; };
static_assert(sizeof(Args) == 25 * 8 + 8 + 8 + 8, "Args has no padding");

__global__ void __launch_bounds__(NWAVES * 64, 2) mega_fwd(Args args) {
    extern __shared__ __attribute__((aligned(16))) unsigned char lds[];
    Frame F;
    F.lds = (LAS unsigned char*)lds;
    F.MISC = (volatile LAS unsigned*)(F.lds + MISC_OFF);
    F.tid = threadIdx.x; F.lane = F.tid & 63; F.wave = __builtin_amdgcn_readfirstlane(F.tid >> 6);
    F.G = gridDim.x; { const int bx = blockIdx.x; F.vcu = (F.G % 8 == 0) ? (bx % 8) * (F.G / 8) + bx / 8 : bx; }
    unsigned char* ws = args.ws;
    F.ctl = (gu32*)(ws + WS_CTL);
    Ptrs P;
#pragma unroll
    for (int i = 0; i < 25; ++i) P.in[i] = args.in[i];
    P.out = args.out; P.ws = ws;
    for (int u = F.tid; u < (LDS_BYTES - LDSCTL_OFF) / 4; u += NWAVES * 64) ((LAS unsigned*)(F.lds + LDSCTL_OFF))[u] = 0u;
    __syncthreads();
    XcdBarrier bar; bar.bar = (unsigned*)(F.ctl + CW_BAR); bar.x = 0; bar.st = nullptr;
    if (!MK_PER_PHASE) bar = xcd_barrier_post((unsigned*)(F.ctl + CW_BAR), F.MISC + 8);
#define GRID_BAR() do { if (!MK_PER_PHASE) xcd_barrier(bar); } while (0)
    const int lo = args.ph_lo, hi = args.ph_hi;
#define IN(k) (lo <= (k) && (k) < hi)
#define BOTH(k) (IN(k) && IN((k) + 1))

    bf16* W1T = (bf16*)(ws + WS_W1T); bf16* WO1T = (bf16*)(ws + WS_WO1T); bf16* W3T = (bf16*)(ws + WS_W3T); bf16* WO2T = (bf16*)(ws + WS_WO2T); bf16* W2T = (bf16*)(ws + WS_W2T);
    bf16* XN = (bf16*)(ws + WS_XN); bf16* Y1 = (bf16*)(ws + WS_Y1); bf16* QL = (bf16*)(ws + WS_QL); bf16* YC = (bf16*)(ws + WS_YC);
    unsigned long long* MASK = (unsigned long long*)(ws + WS_MASK);
    float* stats = (float*)(ws + WS_STATS); const float* mods = (const float*)(ws + WS_MODS);

    if (IN(0)) { p0_prologue(F, P); if (BOTH(0)) GRID_BAR(); }
    if (IN(1)) { xn_phase(F, P.in[0], P.in[4], mods, XN); if (BOTH(1)) GRID_BAR(); }
    if (IN(2)) {
        pg8::Gemm g{XN, W1T, M, N1, 1024, 1024, 1024}; pg8::StaticOrder S; S.init(M, N1, F.G, (int)blockIdx.x);
        pg8::EpiStoreBf16 E{Y1, N1, stats, 6};
        pg8::gemm_phase<pg8::EpiStoreBf16, pg8::StaticOrder, true, true>(F.lds + RING_OFF, g, S, E);
        if (BOTH(2)) GRID_BAR();
    }
    if (IN(3)) {
        pg8::Gemm g{Y1 + Y1_CQ, W2T, M, N2, 256, N1, 256}; pg8::StaticOrder S; S.init(M, N2, F.G, (int)blockIdx.x);
        pg8::EpiScaleBf16 E{QL, N2, stats, 5, EPS};
        pg8::gemm_phase<pg8::EpiScaleBf16, pg8::StaticOrder, true, true>(F.lds + RING_OFF, g, S, E);
        if (BOTH(3)) GRID_BAR();
    }
    if (IN(4)) {
#if FAST_I
        indexer_fast(F, Y1, QL, MASK);
#else
        indexer_naive(F, Y1, QL, MASK);
#endif
        if (BOTH(4)) GRID_BAR(); }
    if (IN(5)) {
#if FAST_A
        attn_phase_a(F, P, Y1, YC);
#else
        diffattn_naive(F, P, Y1, YC);
#endif
        asm volatile("" ::: "memory"); __syncthreads();
#if FAST_B
        attn_phase_b(F, Y1, QL, MASK, YC);
#else
        dsa_naive(F, Y1, QL, MASK, YC);
#endif
        if (BOTH(5)) GRID_BAR(); }
    if (IN(6)) {
        pg8::Gemm g{YC, WO1T, M, 1024, 1024, 1024, 1024}; pg8::StaticOrder S; S.init(M, 1024, F.G, (int)blockIdx.x);
        pg8::EpiResid E{P.in[0], P.out, mods + 2048, 3072};
        pg8::gemm_phase<pg8::EpiResid, pg8::StaticOrder, false, true>(F.lds + RING_OFF, g, S, E);
        if (BOTH(6)) GRID_BAR();
    }
    if (IN(7)) { xn_phase(F, P.out, P.in[4] + 1024, mods + 8 * 3072, XN); if (BOTH(7)) GRID_BAR(); }
    if (IN(8)) {
        pg8::Gemm g{XN, W3T, M, N3, 1024, 1024, 1024}; pg8::StaticOrder S; S.init(M, N3, F.G, (int)blockIdx.x);
        pg8::EpiStoreBf16 E{Y1, N3, nullptr, -1};
        pg8::gemm_phase<pg8::EpiStoreBf16, pg8::StaticOrder, true, true>(F.lds + RING_OFF, g, S, E);
        if (BOTH(8)) GRID_BAR();
    }
    if (IN(9)) {
#if FAST_C
        attn_phase_c(F, P, Y1, YC);
#else
        swa_naive(F, P, Y1, YC); __syncthreads();
#endif
        conv_phase(F, P, Y1, YC); if (BOTH(9)) GRID_BAR(); }
    if (IN(10)) {
        pg8::Gemm g{YC, WO2T, M, 1024, 1024, 1024, 1024}; pg8::StaticOrder S; S.init(M, 1024, F.G, (int)blockIdx.x);
        pg8::EpiResid E{P.out, P.out, mods + 8 * 3072 + 2048, 3072};
        pg8::gemm_phase<pg8::EpiResid, pg8::StaticOrder, false, true>(F.lds + RING_OFF, g, S, E);
        if (BOTH(10)) GRID_BAR();
    }
    if (IN(11)) { final_norm_phase(F, P.out, P.in[24]); }
#undef IN
#undef BOTH
}

extern "C" void kernel_launch(void* const* d_in, const int* in_sizes, int n_in, void* d_out, int out_size, void* d_ws, size_t ws_size, hipStream_t stream) {
    static int grid = 0;
    if (grid == 0) {
        if (n_in != 25 || in_sizes[0] != M * DM || out_size != M * DM || ws_size < WS_END) { fprintf(stderr, "kernel_launch: unexpected shapes (n_in %d, in0 %d, out %d, ws %zu); nothing launched\n", n_in, n_in > 0 ? in_sizes[0] : -1, out_size, ws_size); grid = -1; return; }
        int dev = 0, cus = 0, per_cu = 0;
        if (hipGetDevice(&dev) != hipSuccess || hipDeviceGetAttribute(&cus, hipDeviceAttributeMultiprocessorCount, dev) != hipSuccess) { grid = -1; return; }
        if (hipFuncSetAttribute((const void*)mega_fwd, hipFuncAttributeMaxDynamicSharedMemorySize, LDS_BYTES) != hipSuccess) { fprintf(stderr, "kernel_launch: hipFuncSetAttribute failed\n"); grid = -1; return; }
        if (hipOccupancyMaxActiveBlocksPerMultiprocessor(&per_cu, (const void*)mega_fwd, NWAVES * 64, LDS_BYTES) != hipSuccess || per_cu < 1)
            fprintf(stderr, "kernel_launch: note: occupancy query reports %d workgroups per CU\n", per_cu);
        (void)hipGetLastError();
        grid = cus;
    }
    if (grid < 0) return;
    if (hipMemsetAsync((char*)d_ws + WS_CTL, 0, CTL_ZERO_BYTES, stream) != hipSuccess) { fprintf(stderr, "kernel_launch: hipMemsetAsync failed\n"); return; }
    Args a{};
    for (int i = 0; i < 25; ++i) a.in[i] = (const float*)d_in[i];
    a.out = (float*)d_out; a.ws = (unsigned char*)d_ws;
#if MK_PER_PHASE
    for (int ph = 0; ph < N_PHASES; ++ph) { a.ph_lo = ph; a.ph_hi = ph + 1; hipLaunchKernelGGL(mega_fwd, dim3(grid), dim3(NWAVES * 64), LDS_BYTES, stream, a); }
#else
    a.ph_lo = 0; a.ph_hi = N_PHASES;
    hipLaunchKernelGGL(mega_fwd, dim3(grid), dim3(NWAVES * 64), LDS_BYTES, stream, a);
#endif
    const hipError_t le = hipPeekAtLastError();
    if (le != hipSuccess) fprintf(stderr, "kernel_launch: launch failed: %s\n", hipGetErrorName(le));
}
```
